# Optimizing an MI355X kernel written in HIP

```python
import jax, jax.numpy as jnp
from jax import lax
import numpy as np

D_MODEL = 1024
BATCH = 8
SEQ = 4096
DEPTH = 2

N_MIXERS = 2
N_POOL_GROUPS = 4
POOL_GROUP = D_MODEL // N_POOL_GROUPS
POOL_WINDOWS = (2, 4, 8, 16)
N_HEADS = 16
QK_NOPE = 64
QK_ROPE = 32
V_HEAD = 64
Q_LORA = D_MODEL // 4
KV_LORA = D_MODEL // 8
ROPE_THETA = 10000.0
D_FF = 11 * D_MODEL // 4
Q_BLOCK = 128
EPS = 1e-6
N_MOD = 9
N_POOL_LAYERS = (DEPTH + 1) // 2
N_MLA_LAYERS = DEPTH // 2
ATTN_SCALE = (QK_NOPE + QK_ROPE) ** -0.5

kernel_name = "hybrid_pool_mla_macaron_encoder"


def rmsnorm(x, g):
    xf = x.astype(jnp.float32)
    y = xf * lax.rsqrt(jnp.mean(xf * xf, axis=-1, keepdims=True) + EPS)
    return (y * g.astype(jnp.float32)).astype(x.dtype)


def swiglu(h, w_in, w_out):
    gate, up = jnp.split(h @ w_in, 2, axis=-1)
    return (jax.nn.silu(gate) * up) @ w_out


def centred_mean(x, window):
    s = x.shape[1]
    cs = lax.cumsum(x.astype(jnp.float32), axis=1)
    cs = jnp.pad(cs, ((0, 0), (1, 0), (0, 0)))
    t = jnp.arange(s)
    hi = jnp.clip(t + window // 2, 0, s)
    lo = jnp.clip(t - window // 2, 0, s)
    tot = jnp.take(cs, hi, axis=1) - jnp.take(cs, lo, axis=1)
    cnt = (hi - lo).astype(jnp.float32)[None, :, None]
    return (tot / cnt).astype(x.dtype)


def pool_mixer(h, w, b, scale):
    B, S, _ = h.shape
    hg = h.reshape(B, S, N_POOL_GROUPS, POOL_GROUP)
    pooled = jnp.stack([centred_mean(hg[:, :, g], POOL_WINDOWS[g]) for g in range(N_POOL_GROUPS)], axis=2)
    y = jnp.einsum('bsgc,gcd->bsgd', pooled - hg, w) + b
    return y.reshape(B, S, D_MODEL) * scale


def rope_tables(s, dtype):
    inv = 1.0 / (ROPE_THETA ** (jnp.arange(0, QK_ROPE, 2, dtype=jnp.float32) / QK_ROPE))
    ang = jnp.arange(s, dtype=jnp.float32)[:, None] * inv[None, :]
    return jnp.cos(ang).astype(dtype), jnp.sin(ang).astype(dtype)


def apply_rope(x, cos, sin):
    x1, x2 = jnp.split(x, 2, axis=-1)
    return jnp.concatenate([x1 * cos - x2 * sin, x2 * cos + x1 * sin], axis=-1)


def mla_mixer(h, w_in, q_norm, kv_norm, w_uq, w_uk, w_uv, w_o, cos, sin):
    B, S, _ = h.shape
    lat = h @ w_in
    c_q, c_kv, k_r = jnp.split(lat, [Q_LORA, Q_LORA + KV_LORA], axis=-1)
    c_q = rmsnorm(c_q, q_norm)
    c_kv = rmsnorm(c_kv, kv_norm)
    q = jnp.einsum('bsc,chd->bshd', c_q, w_uq)
    q_nope, q_rope = q[..., :QK_NOPE], q[..., QK_NOPE:]
    q_rope = apply_rope(q_rope, cos[:, None, :], sin[:, None, :]) * ATTN_SCALE
    k_rope = apply_rope(k_r, cos, sin)
    q_lat = jnp.einsum('bshn,chn->bshc', q_nope, w_uk) * ATTN_SCALE
    nb = S // Q_BLOCK
    qlb = q_lat.reshape(B, nb, Q_BLOCK, N_HEADS, KV_LORA).transpose(1, 0, 2, 3, 4)
    qrb = q_rope.reshape(B, nb, Q_BLOCK, N_HEADS, QK_ROPE).transpose(1, 0, 2, 3, 4)

    def block(args):
        ql, qr = args
        s = (jnp.einsum('bqhc,bkc->bhqk', ql, c_kv)
             + jnp.einsum('bqhr,bkr->bhqk', qr, k_rope))
        p = jax.nn.softmax(s.astype(jnp.float32), axis=-1).astype(c_kv.dtype)
        return jnp.einsum('bhqk,bkc->bqhc', p, c_kv)

    o_lat = lax.map(block, (qlb, qrb))
    o_lat = o_lat.transpose(1, 0, 2, 3, 4).reshape(B, S, N_HEADS, KV_LORA)
    o = jnp.einsum('bshc,chv->bshv', o_lat, w_uv)
    return o.reshape(B, S, N_HEADS * V_HEAD) @ w_o


def modulated_sublayer(x, mod, g_pre, g_post, fn, weight):
    shift, scale, gate = mod[:, 0], mod[:, 1], mod[:, 2]
    h = rmsnorm(x, g_pre) * (1.0 + scale) + shift
    y = rmsnorm(fn(h), g_post)
    return x + weight * (1.0 + gate) * y


def setup_inputs(seed: int = 0) -> dict:
    key = jax.random.key(seed)
    ks = jax.random.split(key, 20)
    n = jax.random.normal
    f32 = jnp.float32
    return {
        "x": n(ks[0], (BATCH, SEQ, D_MODEL), f32),
        "c": n(ks[1], (BATCH, D_MODEL), f32),
        "ada_w": n(ks[2], (DEPTH, D_MODEL, N_MOD * D_MODEL), f32) * (0.5 * D_MODEL ** -0.5),
        "ada_b": n(ks[3], (DEPTH, N_MOD * D_MODEL), f32) * 0.01,
        "norm_g": 1.0 + 0.05 * n(ks[4], (DEPTH, 6, D_MODEL), f32),
        "ffn_w_in": n(ks[5], (DEPTH, 2, D_MODEL, 2 * D_FF), f32) * D_MODEL ** -0.5,
        "ffn_w_out": n(ks[6], (DEPTH, 2, D_FF, D_MODEL), f32) * D_FF ** -0.5,
        "pool_w": n(ks[7], (N_POOL_LAYERS, N_POOL_GROUPS, POOL_GROUP, POOL_GROUP), f32) * POOL_GROUP ** -0.5,
        "pool_b": n(ks[8], (N_POOL_LAYERS, N_POOL_GROUPS, POOL_GROUP), f32) * 0.01,
        "pool_scale": 1.0 + 0.05 * n(ks[9], (N_POOL_LAYERS, D_MODEL), f32),
        "mla_w_in": n(ks[10], (N_MLA_LAYERS, D_MODEL, Q_LORA + KV_LORA + QK_ROPE), f32) * D_MODEL ** -0.5,
        "mla_q_norm": 1.0 + 0.05 * n(ks[11], (N_MLA_LAYERS, Q_LORA), f32),
        "mla_kv_norm": 1.0 + 0.05 * n(ks[12], (N_MLA_LAYERS, KV_LORA), f32),
        "mla_w_uq": n(ks[13], (N_MLA_LAYERS, Q_LORA, N_HEADS, QK_NOPE + QK_ROPE), f32) * Q_LORA ** -0.5,
        "mla_w_uk": n(ks[14], (N_MLA_LAYERS, KV_LORA, N_HEADS, QK_NOPE), f32) * KV_LORA ** -0.5,
        "mla_w_uv": n(ks[15], (N_MLA_LAYERS, KV_LORA, N_HEADS, V_HEAD), f32) * KV_LORA ** -0.5,
        "mla_w_o": n(ks[16], (N_MLA_LAYERS, N_HEADS * V_HEAD, D_MODEL), f32) * (N_HEADS * V_HEAD) ** -0.5,
    }


def reference(x, c, ada_w, ada_b, norm_g, ffn_w_in, ffn_w_out, pool_w, pool_b, pool_scale,
              mla_w_in, mla_q_norm, mla_kv_norm, mla_w_uq, mla_w_uk, mla_w_uv, mla_w_o):
    B = x.shape[0]
    cos, sin = rope_tables(x.shape[1], x.dtype)
    sc = jax.nn.silu(c)
    for i in range(DEPTH):
        mod = (sc @ ada_w[i] + ada_b[i]).reshape(B, N_MOD, D_MODEL)[:, :, None, :]
        g = norm_g[i]
        x = modulated_sublayer(x, mod[:, 0:3], g[0], g[1],
                               lambda h: swiglu(h, ffn_w_in[i, 0], ffn_w_out[i, 0]), 0.5)
        if i % N_MIXERS == 0:
            li = i // N_MIXERS
            mixer = lambda h: pool_mixer(h, pool_w[li], pool_b[li], pool_scale[li])
        else:
            li = i // N_MIXERS
            mixer = lambda h: mla_mixer(h, mla_w_in[li], mla_q_norm[li], mla_kv_norm[li],
                                        mla_w_uq[li], mla_w_uk[li], mla_w_uv[li], mla_w_o[li],
                                        cos, sin)
        x = modulated_sublayer(x, mod[:, 3:6], g[2], g[3], mixer, 1.0)
        x = modulated_sublayer(x, mod[:, 6:9], g[4], g[5],
                               lambda h: swiglu(h, ffn_w_in[i, 1], ffn_w_out[i, 1]), 0.5)
    return x
```

```cpp
#include <hip/hip_runtime.h>
#include <hip/hip_cooperative_groups.h>
#include <cstdio>
#include <cstdint>
namespace cg = cooperative_groups;

#define LAS __attribute__((address_space(3)))
typedef unsigned short bf16_t;
typedef short bf16x8 __attribute__((ext_vector_type(8)));
typedef short s16x4 __attribute__((ext_vector_type(4)));
typedef float f32x4 __attribute__((ext_vector_type(4)));
typedef float f32x16 __attribute__((ext_vector_type(16)));
typedef unsigned u32x4 __attribute__((ext_vector_type(4)));
typedef unsigned u32x2 __attribute__((ext_vector_type(2)));
typedef float f32x2_t __attribute__((ext_vector_type(2)));
typedef __bf16 bf16x2_t __attribute__((ext_vector_type(2)));
#define DI __device__ __forceinline__

DI unsigned cvtpk(float lo, float hi) { f32x2_t v = {lo, hi}; bf16x2_t b = __builtin_convertvector(v, bf16x2_t); return __builtin_bit_cast(unsigned, b); }
DI float bflo(unsigned u) { return __uint_as_float(u << 16); }
DI float bfhi(unsigned u) { return __uint_as_float(u & 0xffff0000u); }
DI int opaque_tid() { int t = threadIdx.x; asm volatile("" : "+v"(t)); return t; }
DI float wave_sum(float v) {
#pragma unroll
    for (int o = 1; o < 64; o <<= 1) v += __shfl_xor(v, o);
    return v;
}

constexpr int NB = 8, SEQ = 4096, DM = 1024, NH = 16, FF = 2816, MT = NB * SEQ;
constexpr float EPS = 1e-6f;
constexpr float QSCALE = 0.10206207261596577f * 1.4426950408889634f;
constexpr size_t MiB = 1u << 20;
constexpr size_t WS_CTL = 0, WS_MOD = 1 * MiB, WS_ROPE = 2 * MiB;
constexpr size_t W1_BYTES = (size_t)5632 * 1024 * 2, W2_BYTES = (size_t)1024 * 2816 * 2;
constexpr size_t WS_W1 = 8 * MiB;
constexpr size_t WS_W2 = WS_W1 + 4 * W1_BYTES;
constexpr size_t WS_WP = WS_W2 + 4 * W2_BYTES;
constexpr size_t WS_WLAT = WS_WP + 1024 * 256 * 2;
constexpr size_t WS_WQ = WS_WLAT + 512 * 1024 * 2;
constexpr size_t WS_WUK = WS_WQ + 1536 * 256 * 2;
constexpr size_t WS_WUV = WS_WUK + 1024 * 128 * 2;
constexpr size_t WS_WO = WS_WUV + 1024 * 128 * 2;
constexpr size_t WS_WEND = WS_WO + 1024 * 1024 * 2;
static_assert(WS_WEND <= 88 * MiB, "weights");
constexpr size_t WS_H = 88 * MiB, WS_Y = 152 * MiB, WS_ACT = 216 * MiB;
constexpr size_t WS_LAT = 216 * MiB, WS_CQ = 280 * MiB, WS_CKV = 296 * MiB, WS_KR = 304 * MiB, WS_Q = 306 * MiB, WS_KN = 402 * MiB;
constexpr size_t WS_CKV2 = 466 * MiB;
constexpr size_t WS_VT = WS_H, WS_O = WS_LAT, WS_PD = WS_ACT, WS_END = 474 * MiB;
constexpr int RING_BYTES = 135168, LDS_BYTES = RING_BYTES + 256;
constexpr int CW_BAR = 1024;

namespace pg8 {
constexpr int BM = 256, BK = 64, HALF = 128, HTB = HALF * BK * 2, NXCD = 8, WGM = 8;
DI int lds_byte(int r, int c) { const int st = (r >> 4) * 2 + (c >> 5), rr = r & 15, cc = c & 31, ob = rr * 64 + cc * 2; return st * 1024 + (ob ^ (((ob >> 9) & 1) << 5)); }
DI void stage_rc(int b, int& R, int& C) { const int st = b / 1024, sb = b % 1024, swz = sb ^ (((sb >> 9) & 1) << 5); R = (st >> 1) * 16 + swz / 64; C = (st & 1) * 32 + (swz % 64) / 2; }
DI int perm32(int rho) { const int n = rho >> 4, i = rho & 15; return 8 * (i >> 2) + 4 * n + (i & 3); }
struct Unit { int pm, pn; };
struct Gemm { const bf16_t* A; const bf16_t* Bt; int M, N, K; size_t a_pn_stride; };
struct StaticOrder {
    int nM, nN, nwg, G, c;
    DI void init(int M, int N, int G_, int c_) { nM = M / BM; nN = N / BM; nwg = nM * nN; G = G_; c = c_; }
    DI bool next(int i, Unit& u) const {
        const long L = (long)i * G + c; if (L >= nwg) return false;
        int wgid = (int)L; { const int q = nwg / NXCD, r = nwg % NXCD, xcd = wgid % NXCD, off = wgid / NXCD; wgid = (xcd < r ? xcd * (q + 1) : r * (q + 1) + (xcd - r) * q) + off; }
        const int nig = WGM * nN, gid = wgid / nig, fm = gid * WGM, gsz = (nM - fm) < WGM ? (nM - fm) : WGM;
        u.pm = fm + ((wgid % nig) % gsz); u.pn = (wgid % nig) / gsz; return true;
    }
};

struct EpiStore {
    static constexpr bool AFTER_DRAIN = false;
    bf16_t* O; int ldc; const float* bias; const float* cs;
    DI void operator()(const f32x4 (&acc)[2][2][4][2], const Unit& u, int wr, int wc, int fr, int fq) const {
        const int row0 = u.pm * BM + wr * 64 + fr, col0 = u.pn * BM + wc * 32 + 8 * fq;
        f32x4 bv[2][2], sv[2][2];
#pragma unroll
        for (int bj = 0; bj < 2; ++bj)
#pragma unroll
            for (int n = 0; n < 2; ++n) {
                bv[bj][n] = bias ? *(const f32x4*)(bias + col0 + bj * HALF + 4 * n) : (f32x4){0.f, 0.f, 0.f, 0.f};
                sv[bj][n] = cs ? *(const f32x4*)(cs + col0 + bj * HALF + 4 * n) : (f32x4){1.f, 1.f, 1.f, 1.f};
            }
#pragma unroll
        for (int ai = 0; ai < 2; ++ai)
#pragma unroll
            for (int m = 0; m < 4; ++m) {
                bf16_t* rowp = O + (size_t)(row0 + ai * HALF + m * 16) * ldc + col0;
#pragma unroll
                for (int bj = 0; bj < 2; ++bj) {
                    const f32x4 v0 = (acc[ai][bj][m][0] + bv[bj][0]) * sv[bj][0], v1 = (acc[ai][bj][m][1] + bv[bj][1]) * sv[bj][1];
                    u32x4 w; w.x = cvtpk(v0[0], v0[1]); w.y = cvtpk(v0[2], v0[3]); w.z = cvtpk(v1[0], v1[1]); w.w = cvtpk(v1[2], v1[3]);
                    *(u32x4*)(rowp + bj * HALF) = w;
                }
            }
    }
};
struct EpiF32 {
    static constexpr bool AFTER_DRAIN = false;
    float* O; int ldc;
    DI void operator()(const f32x4 (&acc)[2][2][4][2], const Unit& u, int wr, int wc, int fr, int fq) const {
        const int row0 = u.pm * BM + wr * 64 + fr, col0 = u.pn * BM + wc * 32 + 8 * fq;
#pragma unroll
        for (int ai = 0; ai < 2; ++ai)
#pragma unroll
            for (int m = 0; m < 4; ++m) {
                float* rowp = O + (size_t)(row0 + ai * HALF + m * 16) * ldc + col0;
#pragma unroll
                for (int bj = 0; bj < 2; ++bj) { *(f32x4*)(rowp + bj * HALF) = acc[ai][bj][m][0]; *(f32x4*)(rowp + bj * HALF + 4) = acc[ai][bj][m][1]; }
            }
    }
};
struct EpiSwiglu {
    static constexpr bool AFTER_DRAIN = false;
    bf16_t* O; int ldc;
    DI void operator()(const f32x4 (&acc)[2][2][4][2], const Unit& u, int wr, int wc, int fr, int fq) const {
        const int row0 = u.pm * BM + wr * 64 + fr, col0 = u.pn * HALF + wc * 32 + 8 * fq;
#pragma unroll
        for (int ai = 0; ai < 2; ++ai)
#pragma unroll
            for (int m = 0; m < 4; ++m) {
                float a[8];
#pragma unroll
                for (int n = 0; n < 2; ++n)
#pragma unroll
                    for (int e = 0; e < 4; ++e) {
                        const float g = acc[ai][0][m][n][e], up = acc[ai][1][m][n][e];
                        const float sg = __builtin_amdgcn_rcpf(1.0f + __builtin_amdgcn_exp2f(-1.4426950408889634f * g));
                        a[4 * n + e] = g * sg * up;
                    }
                u32x4 w; w.x = cvtpk(a[0], a[1]); w.y = cvtpk(a[2], a[3]); w.z = cvtpk(a[4], a[5]); w.w = cvtpk(a[6], a[7]);
                *(u32x4*)(O + (size_t)(row0 + ai * HALF + m * 16) * ldc + col0) = w;
            }
    }
};
struct EpiQ {
    static constexpr bool AFTER_DRAIN = false;
    bf16_t* O; const float* cosT; const float* sinT;
    DI void operator()(const f32x4 (&acc)[2][2][4][2], const Unit& u, int wr, int wc, int fr, int fq) const {
        const int row0 = u.pm * BM + wr * 64 + fr, col0 = u.pn * BM + wc * 32 + 8 * fq;
#pragma unroll
        for (int ai = 0; ai < 2; ++ai)
#pragma unroll
            for (int m = 0; m < 4; ++m) {
                const int row = row0 + ai * HALF + m * 16, s = row & (SEQ - 1);
#pragma unroll
                for (int bj = 0; bj < 2; ++bj) {
                    const int col = col0 + bj * HALF, hc = col % 96;
                    f32x4 v0 = acc[ai][bj][m][0], v1 = acc[ai][bj][m][1];
                    if (hc >= 64) {
                        const int j0 = (hc - 64) >> 1;
                        const f32x4 cs = *(const f32x4*)(cosT + s * 16 + j0), sn = *(const f32x4*)(sinT + s * 16 + j0);
                        const f32x4 t0 = v0, t1 = v1;
                        v0[0] = t0[0] * cs[0] - t0[1] * sn[0]; v0[1] = t0[1] * cs[0] + t0[0] * sn[0];
                        v0[2] = t0[2] * cs[1] - t0[3] * sn[1]; v0[3] = t0[3] * cs[1] + t0[2] * sn[1];
                        v1[0] = t1[0] * cs[2] - t1[1] * sn[2]; v1[1] = t1[1] * cs[2] + t1[0] * sn[2];
                        v1[2] = t1[2] * cs[3] - t1[3] * sn[3]; v1[3] = t1[3] * cs[3] + t1[2] * sn[3];
                    }
                    v0 = v0 * QSCALE; v1 = v1 * QSCALE;
                    u32x4 w; w.x = cvtpk(v0[0], v0[1]); w.y = cvtpk(v0[2], v0[3]); w.z = cvtpk(v1[0], v1[1]); w.w = cvtpk(v1[2], v1[3]);
                    *(u32x4*)(O + (size_t)row * 1536 + col) = w;
                }
            }
    }
};

struct EpiLat {
    static constexpr bool AFTER_DRAIN = true;
    const float* qn; const float* kvn; const float* cosT; const float* sinT; bf16_t* CQ; bf16_t* CKV; bf16_t* CKV2; bf16_t* KR;
    DI void operator()(const f32x4 (&)[2][2][4][2], const Unit&, int, int, int, int) const {}
    DI void fused(const f32x4 (&acc)[2][2][4][2], const Unit& u, int wr, int wc, int fr, int fq, LAS unsigned char* lds) const {
        LAS float* P = (LAS float*)lds;
        const bool isq = (u.pn == 0);
#pragma unroll
        for (int ai = 0; ai < 2; ++ai)
#pragma unroll
            for (int m = 0; m < 4; ++m) {
                float s = 0.f;
#pragma unroll
                for (int n = 0; n < 2; ++n) { const f32x4 v = acc[ai][0][m][n]; s += (v[0] * v[0] + v[1] * v[1]) + (v[2] * v[2] + v[3] * v[3]); }
                if (isq) {
#pragma unroll
                    for (int n = 0; n < 2; ++n) { const f32x4 v = acc[ai][1][m][n]; s += (v[0] * v[0] + v[1] * v[1]) + (v[2] * v[2] + v[3] * v[3]); }
                }
                s += __shfl_xor(s, 16); s += __shfl_xor(s, 32);
                if (fq == 0) P[(ai * HALF + wr * 64 + m * 16 + fr) * 4 + wc] = s;
            }
        asm volatile("s_waitcnt lgkmcnt(0)" ::: "memory"); __builtin_amdgcn_s_barrier(); asm volatile("" ::: "memory");
        const float invn = isq ? (1.0f / 256) : (1.0f / 128);
        const int col0 = wc * 32 + 8 * fq;
#pragma unroll
        for (int ai = 0; ai < 2; ++ai)
#pragma unroll
            for (int m = 0; m < 4; ++m) {
                const int rl = ai * HALF + wr * 64 + m * 16 + fr, row = u.pm * BM + rl;
                const f32x4 pp = *(const LAS f32x4*)(P + rl * 4);
                const float rstd = 1.0f / sqrtf(((pp[0] + pp[1]) + (pp[2] + pp[3])) * invn + EPS);
                if (isq) {
#pragma unroll
                    for (int bj = 0; bj < 2; ++bj) {
                        const int col = col0 + bj * HALF;
                        const f32x4 g0 = *(const f32x4*)(qn + col), g1 = *(const f32x4*)(qn + col + 4);
                        const f32x4 v0 = (acc[ai][bj][m][0] * rstd) * g0, v1 = (acc[ai][bj][m][1] * rstd) * g1;
                        u32x4 w; w.x = cvtpk(v0[0], v0[1]); w.y = cvtpk(v0[2], v0[3]); w.z = cvtpk(v1[0], v1[1]); w.w = cvtpk(v1[2], v1[3]);
                        *(u32x4*)(CQ + (size_t)row * 256 + col) = w;
                    }
                } else {
                    {
                        const f32x4 g0 = *(const f32x4*)(kvn + col0), g1 = *(const f32x4*)(kvn + col0 + 4);
                        const f32x4 v0 = (acc[ai][0][m][0] * rstd) * g0, v1 = (acc[ai][0][m][1] * rstd) * g1;
                        u32x4 w; w.x = cvtpk(v0[0], v0[1]); w.y = cvtpk(v0[2], v0[3]); w.z = cvtpk(v1[0], v1[1]); w.w = cvtpk(v1[2], v1[3]);
                        *(u32x4*)(CKV + (size_t)row * 128 + col0) = w;
                        const int j = row & 15, prow = (row & ~15) + ((j >= 4 && j < 8) ? j + 4 : ((j >= 8 && j < 12) ? j - 4 : j));
                        *(u32x4*)(CKV2 + (size_t)prow * 128 + col0) = w;
                    }
                    if (wc == 0) {
                        const int s = row & (SEQ - 1);
                        const f32x4 cs = *(const f32x4*)(cosT + s * 16 + 4 * fq), sn = *(const f32x4*)(sinT + s * 16 + 4 * fq);
                        const f32x4 t0 = acc[ai][1][m][0], t1 = acc[ai][1][m][1];
                        u32x4 w;
                        w.x = cvtpk(t0[0] * cs[0] - t0[1] * sn[0], t0[1] * cs[0] + t0[0] * sn[0]);
                        w.y = cvtpk(t0[2] * cs[1] - t0[3] * sn[1], t0[3] * cs[1] + t0[2] * sn[1]);
                        w.z = cvtpk(t1[0] * cs[2] - t1[1] * sn[2], t1[1] * cs[2] + t1[0] * sn[2]);
                        w.w = cvtpk(t1[2] * cs[3] - t1[3] * sn[3], t1[3] * cs[3] + t1[2] * sn[3]);
                        *(u32x4*)(KR + (size_t)row * 32 + 8 * fq) = w;
                    }
                }
            }
        asm volatile("s_waitcnt lgkmcnt(0)" ::: "memory"); __builtin_amdgcn_s_barrier(); asm volatile("" ::: "memory");
    }
};

template <class Epi, bool ALIGN_EPI = true>
DI void gemm_phase(LAS unsigned char* lds, const Gemm g, const StaticOrder& S, const Epi& E) {
    int tid_ = threadIdx.x; asm volatile("" : "+v"(tid_));
    const int tid = tid_, wid = __builtin_amdgcn_readfirstlane(tid >> 6), lane = tid & 63, wr = wid >> 2, wc = wid & 3, fr = lane & 15, fq = lane >> 4;
    const int K = g.K, nt = K / BK;
    unsigned voffA[2], voffB[2];
#pragma unroll
    for (int i = 0; i < 2; ++i) { int R, C; stage_rc(tid * 16 + i * 8192, R, C); const int Rb = (R & ~31) + perm32(R & 31);
        voffA[i] = (unsigned)(R * K + C) * 2u; voffB[i] = (unsigned)(Rb * K + C) * 2u; }
    const size_t kstep = (size_t)(BK * 2);
    const size_t hstep = (size_t)HALF * K * 2;
    const size_t tstep = 2 * hstep;
    const unsigned ldsw = (unsigned)wid * 1024u;
    const int aoff = lds_byte(wr * 64 + fr, fq * 8), boff = lds_byte(wc * 32 + fr, fq * 8);
#define PG8_SA(b, h) (((b) * 2 + (h)) * HTB)
#define PG8_SB(b, h) ((4 + (b) * 2 + (h)) * HTB)
#define PG8_STAGE(bufoff, gbase, voff) do { _Pragma("unroll") for (int _i = 0; _i < 2; ++_i) { \
        unsigned vo_ = (voff)[_i]; asm volatile("" : "+v"(vo_));     \
        __builtin_amdgcn_global_load_lds((const unsigned*)((const char*)(gbase) + vo_), (LAS unsigned*)(lds + (bufoff) + ldsw + _i * 8192), 16, 0, 0); } } while (0)
#define PG8_LDA(dst, b, h) do { _Pragma("unroll") for (int m = 0; m < 4; ++m) _Pragma("unroll") for (int k = 0; k < 2; ++k) dst[m][k] = *(const LAS bf16x8*)(lds + PG8_SA(b, h) + aoff + m * 2048 + k * 1024); } while (0)
#define PG8_LDB(dst, b, h) do { _Pragma("unroll") for (int n = 0; n < 2; ++n) _Pragma("unroll") for (int k = 0; k < 2; ++k) dst[n][k] = *(const LAS bf16x8*)(lds + PG8_SB(b, h) + boff + n * 2048 + k * 1024); } while (0)
#define PG8_MMA(ai, bj, At, Bt) do { __builtin_amdgcn_s_setprio(1); _Pragma("unroll") for (int m = 0; m < 4; ++m) _Pragma("unroll") for (int n = 0; n < 2; ++n) _Pragma("unroll") for (int k = 0; k < 2; ++k) \
        acc[ai][bj][m][n] = __builtin_amdgcn_mfma_f32_16x16x32_bf16(Bt[n][k], At[m][k], acc[ai][bj][m][n], 0, 0, 0); __builtin_amdgcn_s_setprio(0); } while (0)
#define PG8_WAIT_V(n) asm volatile("s_waitcnt vmcnt(" #n ")" ::: "memory")
#define PG8_WAIT_L(n) asm volatile("s_waitcnt lgkmcnt(" #n ")" ::: "memory")
#define PG8_BAR __builtin_amdgcn_s_barrier()
#define PG8_SCHED __builtin_amdgcn_sched_barrier(0)
    Unit cur, nxt; int ui = 0;
    if (!S.next(0, cur)) return;
    f32x4 acc[2][2][4][2];
#pragma unroll
    for (int a = 0; a < 2; ++a)
#pragma unroll
        for (int b = 0; b < 2; ++b)
#pragma unroll
            for (int m = 0; m < 4; ++m)
#pragma unroll
                for (int n = 0; n < 2; ++n) acc[a][b][m][n] = (f32x4){0.f, 0.f, 0.f, 0.f};
    bf16x8 At[4][2], B0[2][2], B1[2][2];
    const char* cA = (const char*)g.A + (size_t)cur.pm * tstep + (size_t)cur.pn * g.a_pn_stride; const char* cB = (const char*)g.Bt + (size_t)cur.pn * tstep;
    PG8_STAGE(PG8_SB(0, 0), cB, voffB); PG8_STAGE(PG8_SB(0, 1), cB + hstep, voffB); PG8_STAGE(PG8_SA(0, 0), cA, voffA); PG8_STAGE(PG8_SA(0, 1), cA + hstep, voffA);
    if (wr == 1) PG8_BAR;
    PG8_WAIT_V(2); PG8_BAR;
    PG8_STAGE(PG8_SB(1, 0), cB + kstep, voffB); PG8_STAGE(PG8_SA(1, 0), cA + kstep, voffA); PG8_STAGE(PG8_SB(1, 1), cB + hstep + kstep, voffB);
    PG8_WAIT_V(6); PG8_BAR;
    for (;;) {
        const bool has_next = S.next(ui + 1, nxt);
        const char* nA = has_next ? (const char*)g.A + (size_t)nxt.pm * tstep + (size_t)nxt.pn * g.a_pn_stride : cA; const char* nB = has_next ? (const char*)g.Bt + (size_t)nxt.pn * tstep : cB;
        for (int t = 0; t < nt; t += 2) {
            const bool last = (t == nt - 2);
            const char* a1 = cA + (size_t)(t + 1) * kstep;
            const char* a2 = last ? nA : cA + (size_t)(t + 2) * kstep; const char* b2 = last ? nB : cB + (size_t)(t + 2) * kstep;
            const char* a3 = a2 + kstep; const char* b3 = b2 + kstep;
            PG8_LDB(B0, 0, 0); PG8_LDB(B1, 0, 1); PG8_SCHED; PG8_LDA(At, 0, 0); PG8_STAGE(PG8_SA(1, 1), a1 + hstep, voffA);
            PG8_WAIT_V(8); PG8_WAIT_L(0); PG8_BAR; PG8_MMA(0, 0, At, B0); PG8_MMA(0, 1, At, B1); PG8_BAR; PG8_SCHED;
            PG8_LDA(At, 0, 1); PG8_STAGE(PG8_SB(0, 0), b2, voffB); PG8_STAGE(PG8_SB(0, 1), b2 + hstep, voffB); PG8_STAGE(PG8_SA(0, 0), a2, voffA);
            PG8_WAIT_V(8); PG8_WAIT_L(0); PG8_BAR; PG8_MMA(1, 0, At, B0); PG8_MMA(1, 1, At, B1); PG8_BAR; PG8_SCHED;
            PG8_LDB(B0, 1, 0); PG8_LDB(B1, 1, 1); PG8_SCHED; PG8_LDA(At, 1, 0); PG8_STAGE(PG8_SA(0, 1), a2 + hstep, voffA);
            PG8_WAIT_V(8); PG8_WAIT_L(0); PG8_BAR; PG8_MMA(0, 0, At, B0); PG8_MMA(0, 1, At, B1); PG8_BAR; PG8_SCHED;
            PG8_LDA(At, 1, 1); PG8_STAGE(PG8_SB(1, 0), b3, voffB); PG8_STAGE(PG8_SB(1, 1), b3 + hstep, voffB); PG8_STAGE(PG8_SA(1, 0), a3, voffA);
            PG8_WAIT_V(8); PG8_WAIT_L(0); PG8_BAR; PG8_MMA(1, 0, At, B0); PG8_MMA(1, 1, At, B1); PG8_BAR; PG8_SCHED;
        }
        if constexpr (ALIGN_EPI) { if (wr == 0) PG8_BAR; }
        if constexpr (!Epi::AFTER_DRAIN) E(acc, cur, wr, wc, fr, fq);
        if (!has_next) break;
#pragma unroll
        for (int a = 0; a < 2; ++a)
#pragma unroll
            for (int b = 0; b < 2; ++b)
#pragma unroll
                for (int m = 0; m < 4; ++m)
#pragma unroll
                    for (int n = 0; n < 2; ++n) acc[a][b][m][n] = (f32x4){0.f, 0.f, 0.f, 0.f};
        cur = nxt; cA = nA; cB = nB; ++ui;
        if constexpr (ALIGN_EPI) { if (wr == 1) PG8_BAR; }
    }
    PG8_WAIT_V(0);
    if constexpr (!ALIGN_EPI) { if (wr == 0) PG8_BAR; }
    PG8_BAR;
    if constexpr (Epi::AFTER_DRAIN) E.fused(acc, cur, wr, wc, fr, fq, lds);
#undef PG8_SA
#undef PG8_SB
#undef PG8_STAGE
#undef PG8_LDA
#undef PG8_LDB
#undef PG8_MMA
#undef PG8_WAIT_V
#undef PG8_WAIT_L
#undef PG8_BAR
#undef PG8_SCHED
}
}

DI int rowmap(int mode, int n) {
    if (mode == 1) { const int up = n >= FF ? 1 : 0, j = n - up * FF; return (j >> 7) * 256 + up * 128 + (j & 127); }
    if (mode == 2) { const int h = n / 96, d = n - h * 96; if (d < 64) return n; if (d < 80) return h * 96 + 64 + 2 * (d - 64); return h * 96 + 64 + 2 * (d - 80) + 1; }
    if (mode == 3) { if (n < 384) return n; if (n < 400) return 384 + 2 * (n - 384); return 384 + 2 * (n - 400) + 1; }
    return n;
}
DI void transpose_item(const float* W, int K, int N, bf16_t* WT, int mode, int row_off, LAS float* scr, int item, int lane) {
    const int nblk = N / 32, kb = item / nblk, nb = item - kb * nblk, k0 = 64 * kb, n0 = 32 * nb;
#pragma unroll 8
    for (int i = 0; i < 32; ++i) { const int kk = 2 * i + (lane >> 5); scr[kk * 33 + (lane & 31)] = __builtin_nontemporal_load(&W[(size_t)(k0 + kk) * N + n0 + (lane & 31)]); }
    asm volatile("s_waitcnt lgkmcnt(0)" ::: "memory");
    const int c = lane & 7;
#pragma unroll
    for (int j = 0; j < 4; ++j) { const int n = (lane >> 3) + 8 * j; const LAS float* s = scr + (8 * c) * 33 + n;
        u32x4 o; o.x = cvtpk(s[0 * 33], s[1 * 33]); o.y = cvtpk(s[2 * 33], s[3 * 33]); o.z = cvtpk(s[4 * 33], s[5 * 33]); o.w = cvtpk(s[6 * 33], s[7 * 33]);
        *(u32x4*)(WT + (size_t)(row_off + rowmap(mode, n0 + n)) * K + k0 + 8 * c) = o; }
    asm volatile("s_waitcnt lgkmcnt(0)" ::: "memory");
}
DI void ada_item(const float* ada_w, const float* ada_b, float* mod, const LAS float* sc, int item, int lane) {
    const int l = item / 288, n0 = (item - l * 288) * 32, cgp = lane & 7, kr = lane >> 3;
    const float* W = ada_w + (size_t)l * 1024 * 9216 + n0 + 4 * cgp;
    float acc[8][4];
#pragma unroll
    for (int b = 0; b < 8; ++b)
#pragma unroll
        for (int e = 0; e < 4; ++e) acc[b][e] = 0.f;
    for (int k = kr; k < 1024; k += 64) {
        f32x4 w[8];
#pragma unroll
        for (int u = 0; u < 8; ++u) w[u] = __builtin_nontemporal_load((const f32x4*)(W + (size_t)(k + 8 * u) * 9216));
#pragma unroll
        for (int u = 0; u < 8; ++u) {
            const f32x4 s0 = *(const LAS f32x4*)(sc + (k + 8 * u) * 8), s1 = *(const LAS f32x4*)(sc + (k + 8 * u) * 8 + 4);
#pragma unroll
            for (int e = 0; e < 4; ++e) {
                acc[0][e] += s0[0] * w[u][e]; acc[1][e] += s0[1] * w[u][e]; acc[2][e] += s0[2] * w[u][e]; acc[3][e] += s0[3] * w[u][e];
                acc[4][e] += s1[0] * w[u][e]; acc[5][e] += s1[1] * w[u][e]; acc[6][e] += s1[2] * w[u][e]; acc[7][e] += s1[3] * w[u][e];
            }
        }
    }
#pragma unroll
    for (int b = 0; b < 8; ++b)
#pragma unroll
        for (int e = 0; e < 4; ++e) { float v = acc[b][e]; v += __shfl_xor(v, 8); v += __shfl_xor(v, 16); v += __shfl_xor(v, 32); acc[b][e] = v; }
    if (kr == 0) {
        const f32x4 bias = *(const f32x4*)(ada_b + l * 9216 + n0 + 4 * cgp);
#pragma unroll
        for (int b = 0; b < 8; ++b) { f32x4 o = {acc[b][0] + bias[0], acc[b][1] + bias[1], acc[b][2] + bias[2], acc[b][3] + bias[3]}; *(f32x4*)(mod + (size_t)(l * 8 + b) * 9216 + n0 + 4 * cgp) = o; }
    }
}
DI void rope_entry(float* cosT, float* sinT, int idx) {
    const int s = idx >> 4, j = idx & 15, jq = j & 3;
    double pw = jq == 0 ? 1.0 : (jq == 1 ? 1.7782794100389228 : (jq == 2 ? 3.1622776601683795 : 5.623413251903491));
    const int dec = j >> 2; pw *= dec == 0 ? 1.0 : (dec == 1 ? 10.0 : (dec == 2 ? 100.0 : 1000.0));
    const float inv = 1.0f / (float)pw;
    const float ang = (float)s * inv;
    const double a = (double)ang;
    const double kq = __builtin_rint(a * 0.63661977236758134308);
    const double t = (a - kq * 1.5707963267948966192) - kq * 6.123233995736766036e-17;
    const double t2 = t * t;
    const double sn = t * (1.0 + t2 * (-1.0 / 6 + t2 * (1.0 / 120 + t2 * (-1.0 / 5040 + t2 * (1.0 / 362880 + t2 * (-1.0 / 39916800 + t2 * (1.0 / 6227020800.0)))))));
    const double cs = 1.0 + t2 * (-0.5 + t2 * (1.0 / 24 + t2 * (-1.0 / 720 + t2 * (1.0 / 40320 + t2 * (-1.0 / 3628800 + t2 * (1.0 / 479001600.0))))));
    const int q = (int)((long long)kq & 3);
    const double c = q == 0 ? cs : (q == 1 ? -sn : (q == 2 ? -cs : sn));
    const double sv = q == 0 ? sn : (q == 1 ? cs : (q == 2 ? -sn : -cs));
    cosT[idx] = (float)c; sinT[idx] = (float)sv;
}

template <bool POST, bool PRE, bool STOREX, bool XIB, bool XOB>
DI void rows_range(const void* xin, void* xout, const bf16_t* Y, const float* gpost, const float* gate, float w,
                   const float* gpre, const float* shift, const float* scale, bf16_t* Hout, int row0, int rpw, int lane) {
    const int b = row0 >> 12;
    f32x4 ca[4], cb[4], cs[4];
#pragma unroll
    for (int j = 0; j < 4; ++j) {
        if (POST) { const f32x4 gp = ((const f32x4*)gpost)[lane + 64 * j], gt = ((const f32x4*)(gate + (size_t)b * 9216))[lane + 64 * j]; ca[j] = (w * (1.0f + gt)) * gp; }
        if (PRE) { const f32x4 gp = ((const f32x4*)gpre)[lane + 64 * j], sc = ((const f32x4*)(scale + (size_t)b * 9216))[lane + 64 * j]; cb[j] = gp * (1.0f + sc); cs[j] = ((const f32x4*)(shift + (size_t)b * 9216))[lane + 64 * j]; }
    }
    for (int r = 0; r < rpw; r += 2) {
        f32x4 x[2][4]; u32x2 yb[2][4];
#pragma unroll
        for (int q = 0; q < 2; ++q) {
            const int row = row0 + r + q;
            if (XIB) { const u32x2* xr = (const u32x2*)((const bf16_t*)xin + (size_t)row * DM) + lane;
#pragma unroll
                for (int j = 0; j < 4; ++j) { const u32x2 t = xr[64 * j]; x[q][j] = (f32x4){bflo(t.x), bfhi(t.x), bflo(t.y), bfhi(t.y)}; } }
            else { const f32x4* xr = (const f32x4*)((const float*)xin + (size_t)row * DM) + lane;
#pragma unroll
                for (int j = 0; j < 4; ++j) x[q][j] = __builtin_nontemporal_load(&xr[64 * j]); }
            if (POST) { const u32x2* yr = (const u32x2*)(Y + (size_t)row * DM) + lane;
#pragma unroll
                for (int j = 0; j < 4; ++j) yb[q][j] = __builtin_nontemporal_load(&yr[64 * j]); }
        }
#pragma unroll
        for (int q = 0; q < 2; ++q) {
            const int row = row0 + r + q;
            if (POST) {
                f32x4 y[4]; float ss = 0.f;
#pragma unroll
                for (int j = 0; j < 4; ++j) { const u32x2 t = yb[q][j]; y[j] = (f32x4){bflo(t.x), bfhi(t.x), bflo(t.y), bfhi(t.y)}; ss += (y[j][0] * y[j][0] + y[j][1] * y[j][1]) + (y[j][2] * y[j][2] + y[j][3] * y[j][3]); }
                const float rstd = 1.0f / sqrtf(wave_sum(ss) * (1.0f / DM) + EPS);
#pragma unroll
                for (int j = 0; j < 4; ++j) x[q][j] = x[q][j] + ca[j] * (y[j] * rstd);
                if (STOREX) {
                    if (XOB) { u32x2* xo = (u32x2*)((bf16_t*)xout + (size_t)row * DM) + lane;
#pragma unroll
                        for (int j = 0; j < 4; ++j) { u32x2 o; o.x = cvtpk(x[q][j][0], x[q][j][1]); o.y = cvtpk(x[q][j][2], x[q][j][3]); xo[64 * j] = o; } }
                    else { f32x4* xo = (f32x4*)((float*)xout + (size_t)row * DM) + lane;
#pragma unroll
                        for (int j = 0; j < 4; ++j) xo[64 * j] = x[q][j]; }
                }
            }
            if (PRE) {
                float ss = 0.f;
#pragma unroll
                for (int j = 0; j < 4; ++j) ss += (x[q][j][0] * x[q][j][0] + x[q][j][1] * x[q][j][1]) + (x[q][j][2] * x[q][j][2] + x[q][j][3] * x[q][j][3]);
                const float rstd = 1.0f / sqrtf(wave_sum(ss) * (1.0f / DM) + EPS);
                u32x2* ho = (u32x2*)(Hout + (size_t)row * DM) + lane;
#pragma unroll
                for (int j = 0; j < 4; ++j) { const f32x4 h = (x[q][j] * rstd) * cb[j] + cs[j]; u32x2 o; o.x = cvtpk(h[0], h[1]); o.y = cvtpk(h[2], h[3]); ho[64 * j] = o; }
            }
        }
    }
}
template <bool POST, bool PRE, bool XIB, bool XOB>
DI void rows_phase(const void* xin, void* xout, const bf16_t* Y, const float* gpost, const float* gate, float w,
                   const float* gpre, const float* shift, const float* scale, bf16_t* Hout, int vcu, int G) {
    const int tid = opaque_tid(), lane = tid & 63, gw = vcu * 8 + __builtin_amdgcn_readfirstlane(tid >> 6), ngw = G * 8, rpw = MT / ngw;
    rows_range<POST, PRE, true, XIB, XOB>(xin, xout, Y, gpost, gate, w, gpre, shift, scale, Hout, gw * rpw, rpw, lane);
}
DI void lat_rows_phase(const float* LAT, const float* qn, const float* kvn, const float* cosT, const float* sinT, bf16_t* CQ, bf16_t* CKV, bf16_t* CKV2, bf16_t* KR, int vcu, int G) {
    const int tid = opaque_tid(), lane = tid & 63, gw = vcu * 8 + __builtin_amdgcn_readfirstlane(tid >> 6), ngw = G * 8;
    for (int row = gw; row < MT; row += ngw) {
        const float* lr = LAT + (size_t)row * 512;
        const f32x4 q = ((const f32x4*)lr)[lane];
        const f32x4 kv = ((const f32x4*)(lr + 256))[lane & 31];
        float sq = (q[0] * q[0] + q[1] * q[1]) + (q[2] * q[2] + q[3] * q[3]);
        float sk = (kv[0] * kv[0] + kv[1] * kv[1]) + (kv[2] * kv[2] + kv[3] * kv[3]);
        sq = wave_sum(sq);
#pragma unroll
        for (int o = 1; o < 32; o <<= 1) sk += __shfl_xor(sk, o);
        const float rq = 1.0f / sqrtf(sq * (1.0f / 256) + EPS), rk = 1.0f / sqrtf(sk * (1.0f / 128) + EPS);
        const f32x4 gq = ((const f32x4*)qn)[lane], gk = ((const f32x4*)kvn)[lane & 31];
        const f32x4 cq = (q * rq) * gq, ck = (kv * rk) * gk;
        u32x2 o; o.x = cvtpk(cq[0], cq[1]); o.y = cvtpk(cq[2], cq[3]); ((u32x2*)(CQ + (size_t)row * 256))[lane] = o;
        if (lane < 32) { u32x2 p; p.x = cvtpk(ck[0], ck[1]); p.y = cvtpk(ck[2], ck[3]); ((u32x2*)(CKV + (size_t)row * 128))[lane] = p;
            const int j = row & 15, prow = (row & ~15) + ((j >= 4 && j < 8) ? j + 4 : ((j >= 8 && j < 12) ? j - 4 : j));
            ((u32x2*)(CKV2 + (size_t)prow * 128))[lane] = p; }
        if (lane < 16) {
            const int s = row & (SEQ - 1);
            const float x1 = lr[384 + 2 * lane], x2 = lr[385 + 2 * lane], cs = cosT[s * 16 + lane], sn = sinT[s * 16 + lane];
            ((unsigned*)(KR + (size_t)row * 32))[lane] = cvtpk(x1 * cs - x2 * sn, x2 * cs + x1 * sn);
        }
    }
}
template <int W>
DI void pool_chunk(const bf16_t* H, bf16_t* PD, int b, int t0, int tid) {
    constexpr int HW = W / 2, NR = 32 + W - 1;
    const unsigned* src = (const unsigned*)(H + (size_t)b * SEQ * DM) + tid;
    float lo[NR], hi[NR];
#pragma unroll
    for (int i = 0; i < NR; ++i) { const int t = t0 - HW + i; unsigned v = 0u; if (t >= 0 && t < SEQ) v = src[(size_t)t * 512]; lo[i] = bflo(v); hi[i] = bfhi(v); }
    const int g = tid >> 7, c2 = tid & 127;
    unsigned* dst = (unsigned*)(PD + ((size_t)g * MT + (size_t)b * SEQ) * 256) + c2;
#pragma unroll
    for (int i = 0; i < 32; ++i) {
        const int t = t0 + i; int l0 = t - HW, h0 = t + HW; l0 = l0 < 0 ? 0 : l0; h0 = h0 > SEQ ? SEQ : h0;
        float sl = 0.f, sh = 0.f;
#pragma unroll
        for (int k = 0; k < W; ++k) { sl += lo[i + k]; sh += hi[i + k]; }
        const float inv = 1.0f / (float)(h0 - l0);
        dst[(size_t)t * 128] = cvtpk(sl * inv - lo[i + HW], sh * inv - hi[i + HW]);
    }
}

namespace att {
constexpr int KROW = 208, VROW = 144, KBUF = 64 * KROW, VBUF = 64 * VROW;
constexpr float THR = 8.0f;
#define SBAR() __builtin_amdgcn_sched_barrier(0)
#define MFMA32(a, b, c) __builtin_amdgcn_mfma_f32_32x32x16_bf16((a), (b), (c), 0, 0, 0)
DI float xhalf_max(float m) { auto rr = __builtin_amdgcn_permlane32_swap(__float_as_uint(m), __float_as_uint(m), false, false); return fmaxf(__uint_as_float(rr[0]), __uint_as_float(rr[1])); }
DI float xhalf_sum(float m) { auto rr = __builtin_amdgcn_permlane32_swap(__float_as_uint(m), __float_as_uint(m), false, false); return __uint_as_float(rr[0]) + __uint_as_float(rr[1]); }
template <int G> DI void valu_a(const f32x16& P0, const f32x16& P1, float& sacc, u32x4 (&pw)[4]) {
    constexpr int e0 = G * 32 / 12, e1 = (G + 1) * 32 / 12, c0 = G * 16 / 12, c1 = (G + 1) * 16 / 12;
#pragma unroll
    for (int e = e0; e < e1; ++e) sacc += (e < 16 ? P0[e & 15] : P1[e & 15]);
#pragma unroll
    for (int c = c0; c < c1; ++c) { const float lo = (c < 8 ? P0[(2 * c) & 15] : P1[(2 * c) & 15]), hi = (c < 8 ? P0[(2 * c + 1) & 15] : P1[(2 * c + 1) & 15]); pw[c >> 2][c & 3] = cvtpk(lo, hi); }
}
template <int B> DI void exp4(f32x16& X) { X[B] = __builtin_amdgcn_exp2f(X[B]); X[B + 1] = __builtin_amdgcn_exp2f(X[B + 1]); X[B + 2] = __builtin_amdgcn_exp2f(X[B + 2]); X[B + 3] = __builtin_amdgcn_exp2f(X[B + 3]); }
DI float max3f(float a, float b, float c) { float r; asm("v_max3_f32 %0, %1, %2, %3" : "=v"(r) : "v"(a), "v"(b), "v"(c)); return r; }
DI float max16x2(const f32x16& a, const f32x16& b) {
    float m0 = max3f(a[0], a[1], b[0]), m1 = max3f(a[2], a[3], b[1]); m0 = max3f(m0, b[2], b[3]);
#pragma unroll
    for (int r = 4; r < 16; r += 4) { m0 = max3f(m0, a[r], a[r + 1]); m1 = max3f(m1, a[r + 2], a[r + 3]); m0 = max3f(m0, b[r], b[r + 1]); m1 = max3f(m1, b[r + 2], b[r + 3]); }
    return max3f(m0, m1, m1);
}
DI bf16x8 vfrag(const LAS unsigned char* p) { return *(const LAS bf16x8*)p; }

constexpr int NS = 6, STG = KBUF + VBUF;
DI void unit(LAS unsigned char* lds, const bf16_t* Q, const bf16_t* KN, const bf16_t* KR, const bf16_t* VT, bf16_t* O, int b, int h, int qb) {
    const int tid = opaque_tid(), lane = tid & 63, wid = __builtin_amdgcn_readfirstlane(tid >> 6), r32 = lane & 31, hi = lane >> 5;
    const size_t tok0 = (size_t)b * SEQ;
    const char* gp[3]; unsigned gstep[3]; int loff[3];
#pragma unroll
    for (int i = 0; i < 3; ++i) {
        const int j = wid * 3 + i;
        if (j < 13) {
            const int c = 64 * j + lane, row = c / 13, col = c - 13 * row;
            if (col >= 8 && col < 12) { gp[i] = (const char*)(KR + (tok0 + row) * 32 + 8 * (col - 8)); gstep[i] = 64u * 32u * 2u; }
            else { gp[i] = (const char*)(KN + (tok0 + row) * 1024 + h * 64 + 8 * (col & 7)); gstep[i] = 64u * 1024u * 2u; }
            loff[i] = j * 1024;
        } else {
            const int jj = j < 22 ? j - 13 : j - 22, c = 64 * jj + lane, row = c / 9, col = c - 9 * row;
            gp[i] = (const char*)(VT + (size_t)(h * 64 + row) * MT + tok0 + 8 * (col & 7)); gstep[i] = 128u;
            loff[i] = KBUF + jj * 1024;
        }
    }
#define DMA_TILE(T) do { const int tt_ = (T) < SEQ / 64 ? (T) : SEQ / 64 - 1; const int sl_ = (T) % NS; \
    _Pragma("unroll") for (int i_ = 0; i_ < 3; ++i_) \
        __builtin_amdgcn_global_load_lds((const unsigned*)(gp[i_] + (size_t)tt_ * gstep[i_]), (LAS unsigned*)(lds + sl_ * STG + loff[i_]), 16, 0, 0); } while (0)
#define WAIT_BAR(N) do { asm volatile("s_waitcnt vmcnt(" #N ") lgkmcnt(0)" ::: "memory"); __builtin_amdgcn_s_barrier(); asm volatile("" ::: "memory"); } while (0)
    const int kofs = r32 * KROW + 16 * hi, vofs = KBUF + r32 * VROW + 16 * hi;
    DMA_TILE(0); DMA_TILE(1); DMA_TILE(2); DMA_TILE(3);
    const bf16_t* qp = Q + (tok0 + qb * 256 + wid * 32 + r32) * 1536 + h * 96 + 8 * hi;
    bf16x8 qf[6];
#pragma unroll
    for (int d0 = 0; d0 < 6; ++d0) qf[d0] = __builtin_nontemporal_load((const bf16x8*)(qp + 16 * d0));
    f32x16 o0, o1, negm, pA0, pA1, pB0, pB1;
#pragma unroll
    for (int r = 0; r < 16; ++r) { o0[r] = 0.f; o1[r] = 0.f; negm[r] = 0.f; }
    float mhat = 0.f, lrun = 0.f;
    asm volatile("s_waitcnt vmcnt(0)" ::: "memory");
    __builtin_amdgcn_s_barrier(); asm volatile("" ::: "memory");
    DMA_TILE(4);
    bf16x8 kf[12], vf[8];
    {
        const LAS unsigned char* kb = lds + kofs;
#pragma unroll
        for (int d0 = 0; d0 < 6; ++d0) { kf[2 * d0] = *(const LAS bf16x8*)(kb + 32 * d0); kf[2 * d0 + 1] = *(const LAS bf16x8*)(kb + 32 * KROW + 32 * d0); }
#pragma unroll
        for (int d0 = 0; d0 < 6; ++d0) { pA0 = MFMA32(kf[2 * d0], qf[d0], d0 == 0 ? negm : pA0); pA1 = MFMA32(kf[2 * d0 + 1], qf[d0], d0 == 0 ? negm : pA1); }
        mhat = xhalf_max(max16x2(pA0, pA1));
#pragma unroll
        for (int r = 0; r < 16; ++r) { pA0[r] = __builtin_amdgcn_exp2f(pA0[r] - mhat); pA1[r] = __builtin_amdgcn_exp2f(pA1[r] - mhat); negm[r] = -mhat; }
        const LAS unsigned char* kb1 = lds + STG + kofs;
#pragma unroll
        for (int d0 = 0; d0 < 6; ++d0) { kf[2 * d0] = *(const LAS bf16x8*)(kb1 + 32 * d0); kf[2 * d0 + 1] = *(const LAS bf16x8*)(kb1 + 32 * KROW + 32 * d0); }
    }
    WAIT_BAR(3);
#define PIN(x) asm volatile("" : "+v"(x))
#define VRD(i) vf[i] = *(const LAS bf16x8*)(vb + ((i) & 1) * 32 * VROW + ((i) >> 1) * 32)
#define KRD(i) kf[i] = *(const LAS bf16x8*)(kbn + ((i) & 1) * 32 * KROW + ((i) >> 1) * 32)
#define QKSTEP(C0, C1, P0, P1, d0, G0, G1) \
    if (G0 < 8) VRD(G0); \
    C0 = MFMA32(kf[2 * d0], qf[d0], d0 == 0 ? negm : C0); valu_a<G0>(P0, P1, sacc, pw); PIN(sacc); PIN(pw[(G0 * 16 / 12) >> 2]); SBAR(); \
    if (G1 < 8) VRD(G1); \
    C1 = MFMA32(kf[2 * d0 + 1], qf[d0], d0 == 0 ? negm : C1); valu_a<G1>(P0, P1, sacc, pw); PIN(sacc); PIN(pw[(G1 * 16 / 12) >> 2]); SBAR();
#define PVSTEP(ks, X, B) \
    if (ks < 2) { KRD(4 * ks); KRD(4 * ks + 1); } else { KRD(2 * ks + 4); } \
    o0 = MFMA32(vf[2 * ks], __builtin_bit_cast(bf16x8, pw[ks]), o0); exp4<B>(X); PIN(X); SBAR(); \
    if (ks < 2) { KRD(4 * ks + 2); KRD(4 * ks + 3); } else { KRD(2 * ks + 5); } \
    o1 = MFMA32(vf[2 * ks + 1], __builtin_bit_cast(bf16x8, pw[ks]), o1); exp4<B + 4>(X); PIN(X); SBAR();
#define STEP(C0, C1, P0, P1, T, DOMAX) do { \
    const int t_ = (T); \
    DMA_TILE(t_ + 4); \
    const LAS unsigned char* vb = lds + ((t_ - 1) % NS) * STG + vofs; \
    const LAS unsigned char* kbn = lds + ((t_ + 1) % NS) * STG + kofs; \
    asm volatile("" : "+v"(vb), "+v"(kbn));     \
    float sacc = 0.f; u32x4 pw[4]; \
    SBAR(); __builtin_amdgcn_s_setprio(1); \
    QKSTEP(C0, C1, P0, P1, 0, 0, 1) QKSTEP(C0, C1, P0, P1, 1, 2, 3) QKSTEP(C0, C1, P0, P1, 2, 4, 5) \
    QKSTEP(C0, C1, P0, P1, 3, 6, 7) QKSTEP(C0, C1, P0, P1, 4, 8, 9) QKSTEP(C0, C1, P0, P1, 5, 10, 11) \
    __builtin_amdgcn_s_setprio(0); lrun += sacc; \
    float rm = 0.f; if (DOMAX) rm = xhalf_max(max16x2(C0, C1));     \
    SBAR(); \
    PVSTEP(0, C0, 0) PVSTEP(1, C0, 8) PVSTEP(2, C1, 0) PVSTEP(3, C1, 8) \
    WAIT_BAR(6); \
    if (DOMAX) if (__builtin_expect(__any(rm > THR), 0)) { const float dl = fmaxf(rm, 0.f), fres = __builtin_amdgcn_exp2f(-dl); mhat += dl; lrun *= fres; \
        _Pragma("unroll") for (int r = 0; r < 16; ++r) { C0[r] *= fres; C1[r] *= fres; o0[r] *= fres; o1[r] *= fres; negm[r] = -mhat; } \
        PIN(C0); PIN(C1); PIN(o0); PIN(o1); PIN(negm); } \
    } while (0)
    int t = 1;
    for (; t + 1 < SEQ / 64; t += 2) {
        STEP(pB0, pB1, pA0, pA1, t, true);
        STEP(pA0, pA1, pB0, pB1, t + 1, false);
    }
    STEP(pB0, pB1, pA0, pA1, SEQ / 64 - 1, true);
    {
        float sacc = 0.f; u32x4 pw[4];
        valu_a<0>(pB0, pB1, sacc, pw); valu_a<1>(pB0, pB1, sacc, pw); valu_a<2>(pB0, pB1, sacc, pw); valu_a<3>(pB0, pB1, sacc, pw);
        valu_a<4>(pB0, pB1, sacc, pw); valu_a<5>(pB0, pB1, sacc, pw); valu_a<6>(pB0, pB1, sacc, pw); valu_a<7>(pB0, pB1, sacc, pw);
        valu_a<8>(pB0, pB1, sacc, pw); valu_a<9>(pB0, pB1, sacc, pw); valu_a<10>(pB0, pB1, sacc, pw); valu_a<11>(pB0, pB1, sacc, pw);
        lrun += sacc;
        const LAS unsigned char* vb = lds + ((SEQ / 64 - 1) % NS) * STG + vofs;
#pragma unroll
        for (int ks = 0; ks < 4; ++ks) {
            o0 = MFMA32(vfrag(vb + 32 * ks), __builtin_bit_cast(bf16x8, pw[ks]), o0);
            o1 = MFMA32(vfrag(vb + 32 * VROW + 32 * ks), __builtin_bit_cast(bf16x8, pw[ks]), o1);
        }
    }
#undef STEP
#undef QKSTEP
#undef PVSTEP
#undef PIN
#undef VRD
#undef KRD
    const float inv = 1.0f / xhalf_sum(lrun);
    bf16_t* orow = O + (tok0 + qb * 256 + wid * 32 + r32) * 1024 + h * 64 + 8 * hi;
#pragma unroll
    for (int dt = 0; dt < 2; ++dt)
#pragma unroll
        for (int g = 0; g < 4; g += 2) {
            const f32x16& oo = dt == 0 ? o0 : o1;
            u32x2 a, b;
            a.x = cvtpk(oo[4 * g] * inv, oo[4 * g + 1] * inv); a.y = cvtpk(oo[4 * g + 2] * inv, oo[4 * g + 3] * inv);
            b.x = cvtpk(oo[4 * g + 4] * inv, oo[4 * g + 5] * inv); b.y = cvtpk(oo[4 * g + 6] * inv, oo[4 * g + 7] * inv);
            { auto r = __builtin_amdgcn_permlane32_swap(a.x, b.x, false, false); a.x = r[0]; b.x = r[1]; }
            { auto r = __builtin_amdgcn_permlane32_swap(a.y, b.y, false, false); a.y = r[0]; b.y = r[1]; }
            u32x4 w; w.x = a.x; w.y = a.y; w.z = b.x; w.w = b.y;
            *(u32x4*)(orow + 32 * dt + 8 * g) = w;
        }
    WAIT_BAR(0);
#undef DMA_TILE
#undef WAIT_BAR
}
#undef SBAR
#undef MFMA32
}

typedef __attribute__((address_space(1))) unsigned gu32;
#define RLX_AGENT __ATOMIC_RELAXED, __HIP_MEMORY_SCOPE_AGENT
#define XB_TMO      128
#define XB_XCNT(j)  (256  + 64 * (j))
#define XB_XSUB(j)  (1280 + 64 * (j))
#define XB_XGEN(j)  (2304 + 64 * (j))
#define XB_TOP      3328
#define XB_TOPGEN   3392
#define XCD_BAR_WORDS 3456
#define XB_SPIN_CAP (1u << 18)

__device__ __forceinline__ unsigned xb_ld(unsigned* p)              { return __hip_atomic_load(p, __ATOMIC_RELAXED, __HIP_MEMORY_SCOPE_AGENT); }
__device__ __forceinline__ unsigned xb_add(unsigned* p, unsigned v) { return __hip_atomic_fetch_add(p, v, __ATOMIC_RELAXED, __HIP_MEMORY_SCOPE_AGENT); }
__device__ __forceinline__ unsigned xb_xcc_id() { return (unsigned)__builtin_amdgcn_s_getreg((3 << 11) | 20) & 0xFu; }
#define XB_SPIN(cond, bar) do { unsigned _sp = 0; while (cond) { __builtin_amdgcn_s_sleep(1); \
    if ((++_sp & 255u) == 0u) { if (xb_ld(&(bar)[XB_TMO])) break; if (_sp > XB_SPIN_CAP) { atomicAdd(&(bar)[XB_TMO], 1u); break; } } } } while (0)

struct XcdBarrier {
    unsigned* bar; unsigned x;
    volatile LAS unsigned* st;
};

__device__ __forceinline__ XcdBarrier xcd_barrier_post(unsigned* bar, volatile LAS unsigned* st) {
    XcdBarrier b; b.bar = bar; b.x = xb_xcc_id(); b.st = st;
    if (threadIdx.x == 0) (void)xb_add(&bar[XB_XCNT(b.x)], 1u);
    return b;
}
__device__ __forceinline__ void xcd_barrier_complete(unsigned* bar, unsigned x, unsigned& nloc, unsigned& nx) {
    const unsigned G = gridDim.x * gridDim.y * gridDim.z;
    unsigned sum, cnt, mine, sp = 0u;
    for (;;) {
        sum = 0u; cnt = 0u; mine = 0u;
#pragma unroll
        for (unsigned j = 0; j < 16; ++j) { const unsigned c = xb_ld(&bar[XB_XCNT(j)]); sum += c; cnt += (c > 0u) ? 1u : 0u; mine = (j == x) ? c : mine; }
        if (sum == G) break;
        __builtin_amdgcn_s_sleep(1);
        if ((++sp & 255u) == 0u) { if (xb_ld(&bar[XB_TMO])) break; if (sp > XB_SPIN_CAP) { atomicAdd(&bar[XB_TMO], 1u); break; } }
    }
    nloc = mine > 0u ? mine : 1u; nx = cnt > 0u ? cnt : 1u;
}

__device__ __forceinline__ void xcd_barrier(const XcdBarrier& b) {
    asm volatile("s_waitcnt vmcnt(0)" ::: "memory");
    __syncthreads();
    if (threadIdx.x == 0) {
        unsigned* bar = b.bar;
        __builtin_amdgcn_s_waitcnt(0);
        unsigned nloc = b.st[0], nx = b.st[1];
        if (nloc == 0u) { xcd_barrier_complete(bar, b.x, nloc, nx); b.st[0] = nloc; b.st[1] = nx; }
        const unsigned old = xb_add(&bar[XB_XSUB(b.x)], 1u);
        const unsigned gen = old / nloc;
        if (old + 1u == (gen + 1u) * nloc) {
            __builtin_amdgcn_fence(__ATOMIC_RELEASE, "agent");
            asm volatile("s_waitcnt vmcnt(0)" ::: "memory");
            const unsigned og = xb_add(&bar[XB_TOP], 1u);
            const unsigned tg = og / nx;
            if (og + 1u == (tg + 1u) * nx) xb_add(&bar[XB_TOPGEN], 1u);
            else XB_SPIN(xb_ld(&bar[XB_TOPGEN]) == tg, bar);
            __builtin_amdgcn_fence(__ATOMIC_ACQUIRE, "agent");
            xb_add(&bar[XB_XGEN(b.x)], 1u);
            asm volatile("s_waitcnt vmcnt(0)" ::: "memory");
        } else {
            XB_SPIN(xb_ld(&bar[XB_XGEN(b.x)]) == gen, bar);
            __builtin_amdgcn_fence(__ATOMIC_ACQUIRE, "agent");
            asm volatile("s_waitcnt vmcnt(0)" ::: "memory");
        }
    }
    __syncthreads();
}

struct Args { const float* in[17]; float* out; unsigned char* ws; };
__global__ void __launch_bounds__(512, 2) fwd_megakernel(Args a) {
    extern __shared__ __attribute__((aligned(16))) unsigned char lds_raw[];
    LAS unsigned char* lds = (LAS unsigned char*)lds_raw;
    cg::grid_group grid = cg::this_grid();
    const int G = gridDim.x, bx = blockIdx.x;
    const int vcu = (G % 8 == 0) ? (bx % 8) * (G / 8) + bx / 8 : bx;
    unsigned char* ws = a.ws;
    const float* x_in = a.in[0]; const float* c_in = a.in[1]; const float* ada_w = a.in[2]; const float* ada_b = a.in[3]; const float* norm_g = a.in[4];
    const float* ffn_w_in = a.in[5]; const float* ffn_w_out = a.in[6]; const float* pool_w = a.in[7]; const float* pool_b = a.in[8]; const float* pool_scale = a.in[9];
    const float* mla_w_in = a.in[10]; const float* mla_q_norm = a.in[11]; const float* mla_kv_norm = a.in[12]; const float* mla_w_uq = a.in[13];
    const float* mla_w_uk = a.in[14]; const float* mla_w_uv = a.in[15]; const float* mla_w_o = a.in[16];
    float* X = a.out;
    bf16_t* XB = (bf16_t*)a.out;
    bf16_t* XB2 = (bf16_t*)(ws + WS_KN);
    float* mod = (float*)(ws + WS_MOD);
    float* cosT = (float*)(ws + WS_ROPE); float* sinT = cosT + SEQ * 16;
    bf16_t* Hb = (bf16_t*)(ws + WS_H); bf16_t* Yb = (bf16_t*)(ws + WS_Y); bf16_t* ACT = (bf16_t*)(ws + WS_ACT);
    bf16_t* Wp_t = (bf16_t*)(ws + WS_WP); bf16_t* Wlat_t = (bf16_t*)(ws + WS_WLAT); bf16_t* Wq_t = (bf16_t*)(ws + WS_WQ);
    bf16_t* Wuk_t = (bf16_t*)(ws + WS_WUK); bf16_t* Wuv_t = (bf16_t*)(ws + WS_WUV); bf16_t* Wo_t = (bf16_t*)(ws + WS_WO);
    float* LAT = (float*)(ws + WS_LAT); bf16_t* CQ = (bf16_t*)(ws + WS_CQ); bf16_t* CKV = (bf16_t*)(ws + WS_CKV); bf16_t* CKV2 = (bf16_t*)(ws + WS_CKV2); bf16_t* KR = (bf16_t*)(ws + WS_KR);
    bf16_t* Qb = (bf16_t*)(ws + WS_Q); bf16_t* KN = (bf16_t*)(ws + WS_KN); bf16_t* VT = (bf16_t*)(ws + WS_VT); bf16_t* Ob = (bf16_t*)(ws + WS_O); bf16_t* PD = (bf16_t*)(ws + WS_PD);
    if (threadIdx.x < 64) ((LAS unsigned*)(lds + RING_BYTES))[threadIdx.x] = 0u;
    __syncthreads();
    const XcdBarrier xbar = xcd_barrier_post((unsigned*)(ws + WS_CTL) + CW_BAR, (volatile LAS unsigned*)(lds + RING_BYTES) + 8);
#define GRID_SYNC() xcd_barrier(xbar)
#define MODP(l, i) (mod + (size_t)(l) * 8 * 9216 + (i) * 1024)
#define NG(l, i) (norm_g + ((l) * 6 + (i)) * 1024)

    {
        const int tid = opaque_tid(), lane = tid & 63, wave = __builtin_amdgcn_readfirstlane(tid >> 6), gw = vcu * 8 + wave, ngw = G * 8;
        LAS float* sc = (LAS float*)(lds + 69632);
        for (int idx = tid; idx < 8192; idx += 512) { const float v = c_in[idx]; sc[(idx & 1023) * 8 + (idx >> 10)] = v / (1.0f + __expf(-v)); }
        __syncthreads();
        LAS float* scr = (LAS float*)(lds + wave * 8448);
        constexpr int I_W1 = 16 * 176, I_W2 = 44 * 32, I_WP = 4 * 8, I_WLAT = 16 * 13, I_WQ = 4 * 48, I_WUK = 2 * 32, I_WO = 16 * 32, I_ADA = 576;
        constexpr int NITEMS = I_ADA + 4 * I_W1 + 4 * I_W2 + 4 * I_WP + I_WLAT + I_WQ + 2 * I_WUK + I_WO;
        constexpr int NTR = NITEMS - I_ADA;
        const bool split = ngw > I_ADA;
        if (gw < I_ADA) ada_item(ada_w, ada_b, mod, sc, gw, lane);
        if (!split) for (int it = gw + ngw; it < I_ADA; it += ngw) ada_item(ada_w, ada_b, mod, sc, it, lane);
        const int tr_first = split ? (gw < I_ADA ? gw : I_ADA + (gw - I_ADA)) : gw, tr_step = split ? (gw < I_ADA ? NTR : ngw - I_ADA) : ngw;
        for (int it = tr_first; it < NTR; it += tr_step) {
            int r = it;
            if (r < 4 * I_W1) { const int q = r / I_W1; transpose_item(ffn_w_in + (size_t)q * 1024 * 5632, 1024, 5632, (bf16_t*)(ws + WS_W1 + q * W1_BYTES), 1, 0, scr, r - q * I_W1, lane); continue; } r -= 4 * I_W1;
            if (r < 4 * I_W2) { const int q = r / I_W2; transpose_item(ffn_w_out + (size_t)q * 2816 * 1024, 2816, 1024, (bf16_t*)(ws + WS_W2 + q * W2_BYTES), 0, 0, scr, r - q * I_W2, lane); continue; } r -= 4 * I_W2;
            if (r < 4 * I_WP) { const int q = r / I_WP; transpose_item(pool_w + (size_t)q * 65536, 256, 256, Wp_t, 0, q * 256, scr, r - q * I_WP, lane); continue; } r -= 4 * I_WP;
            if (r < I_WLAT) { transpose_item(mla_w_in, 1024, 416, Wlat_t, 3, 0, scr, r, lane); continue; } r -= I_WLAT;
            if (r < I_WQ) { transpose_item(mla_w_uq, 256, 1536, Wq_t, 2, 0, scr, r, lane); continue; } r -= I_WQ;
            if (r < I_WUK) { transpose_item(mla_w_uk, 128, 1024, Wuk_t, 0, 0, scr, r, lane); continue; } r -= I_WUK;
            if (r < I_WUK) { transpose_item(mla_w_uv, 128, 1024, Wuv_t, 0, 0, scr, r, lane); continue; } r -= I_WUK;
            transpose_item(mla_w_o, 1024, 1024, Wo_t, 0, 0, scr, r, lane);
        }
        for (int idx = bx * 512 + tid; idx < SEQ * 16; idx += G * 512) rope_entry(cosT, sinT, idx);
        for (int idx = bx * 512 + tid; idx < 96 * 1024 / 8; idx += G * 512) ((u32x4*)(Wlat_t + 416 * 1024))[idx] = (u32x4){0u, 0u, 0u, 0u};
    }
    GRID_SYNC();
    if (gridDim.x > 1048576u) grid.sync();
    rows_phase<false, true, false, false>(x_in, nullptr, nullptr, nullptr, nullptr, 0.f, NG(0, 0), MODP(0, 0), MODP(0, 1), Hb, vcu, G);
    GRID_SYNC();

#define FFN_PHASE(l, f) do { \
        { pg8::Gemm g{Hb, (const bf16_t*)(ws + WS_W1 + (size_t)((l) * 2 + (f)) * W1_BYTES), MT, 2 * FF, DM, 0}; pg8::StaticOrder S; S.init(MT, 2 * FF, G, bx); \
          pg8::EpiSwiglu E{ACT, FF}; pg8::gemm_phase(lds, g, S, E); } \
        GRID_SYNC(); \
        { pg8::Gemm g{ACT, (const bf16_t*)(ws + WS_W2 + (size_t)((l) * 2 + (f)) * W2_BYTES), MT, DM, FF, 0}; pg8::StaticOrder S; S.init(MT, DM, G, bx); \
          pg8::EpiStore E{Yb, DM, nullptr, nullptr}; pg8::gemm_phase<pg8::EpiStore, false>(lds, g, S, E); } \
        GRID_SYNC(); } while (0)

    FFN_PHASE(0, 0);
    rows_phase<true, true, false, true>(x_in, XB, Yb, NG(0, 1), MODP(0, 2), 0.5f, NG(0, 2), MODP(0, 3), MODP(0, 4), Hb, vcu, G);
    if (MT % (G * 32) == 0) {
        const int tid = opaque_tid(), lane = tid & 63, wave = __builtin_amdgcn_readfirstlane(tid >> 6);
        const int rpb = MT / G, r0 = vcu * rpb, tb = r0 & (SEQ - 1);
        const int hrow = wave < 4 ? r0 - 8 + 2 * wave : r0 + rpb + 2 * (wave - 4);
        const bool hvalid = wave < 4 ? (tb >= 8) : (tb + rpb + 8 <= SEQ);
        if (hvalid) rows_range<true, true, false, false, false>(x_in, nullptr, Yb, NG(0, 1), MODP(0, 2), 0.5f, NG(0, 2), MODP(0, 3), MODP(0, 4), Hb, hrow, 2, lane);
        asm volatile("s_waitcnt vmcnt(0)" ::: "memory");
        __syncthreads();
        if (tid == 0) { __builtin_amdgcn_fence(__ATOMIC_ACQUIRE, "agent"); asm volatile("s_waitcnt vmcnt(0)" ::: "memory"); }
        __syncthreads();
        for (int ci = r0 / 32; ci < (r0 + rpb) / 32; ++ci) {
            const int b = ci >> 7, t0 = (ci & 127) * 32, gsel = wave >> 1;
            if (gsel == 0) pool_chunk<2>(Hb, PD, b, t0, tid);
            else if (gsel == 1) pool_chunk<4>(Hb, PD, b, t0, tid);
            else if (gsel == 2) pool_chunk<8>(Hb, PD, b, t0, tid);
            else pool_chunk<16>(Hb, PD, b, t0, tid);
        }
    } else {
        GRID_SYNC();
        for (int ci = vcu; ci < MT / 32; ci += G) {
            const int tid = opaque_tid(), wave = __builtin_amdgcn_readfirstlane(tid >> 6);
            const int b = ci >> 7, t0 = (ci & 127) * 32, gsel = wave >> 1;
            if (gsel == 0) pool_chunk<2>(Hb, PD, b, t0, tid);
            else if (gsel == 1) pool_chunk<4>(Hb, PD, b, t0, tid);
            else if (gsel == 2) pool_chunk<8>(Hb, PD, b, t0, tid);
            else pool_chunk<16>(Hb, PD, b, t0, tid);
        }
    }
    GRID_SYNC();
    {
        pg8::Gemm g{PD, Wp_t, MT, DM, 256, (size_t)MT * 256 * 2}; pg8::StaticOrder S; S.init(MT, DM, G, bx);
        pg8::EpiStore E{Yb, DM, pool_b, pool_scale};
        pg8::gemm_phase<pg8::EpiStore, false>(lds, g, S, E);
    }
    GRID_SYNC();
    rows_phase<true, true, true, true>(XB, XB, Yb, NG(0, 3), MODP(0, 5), 1.0f, NG(0, 4), MODP(0, 6), MODP(0, 7), Hb, vcu, G);
    GRID_SYNC();
    FFN_PHASE(0, 1);
    rows_phase<true, true, true, true>(XB, XB, Yb, NG(0, 5), MODP(0, 8), 0.5f, NG(1, 0), MODP(1, 0), MODP(1, 1), Hb, vcu, G);
    GRID_SYNC();

    FFN_PHASE(1, 0);
    rows_phase<true, true, true, true>(XB, XB, Yb, NG(1, 1), MODP(1, 2), 0.5f, NG(1, 2), MODP(1, 3), MODP(1, 4), Hb, vcu, G);
    GRID_SYNC();
    if (G * 1 == (MT / 256) * 2) {
        pg8::Gemm g{Hb, Wlat_t, MT, 512, DM, 0}; pg8::StaticOrder S; S.init(MT, 512, G, bx);
        pg8::EpiLat E{mla_q_norm, mla_kv_norm, cosT, sinT, CQ, CKV, CKV2, KR};
        pg8::gemm_phase(lds, g, S, E);
    } else {
        {
            pg8::Gemm g{Hb, Wlat_t, MT, 512, DM, 0}; pg8::StaticOrder S; S.init(MT, 512, G, bx);
            pg8::EpiF32 E{LAT, 512};
            pg8::gemm_phase(lds, g, S, E);
        }
        GRID_SYNC();
        lat_rows_phase(LAT, mla_q_norm, mla_kv_norm, cosT, sinT, CQ, CKV, CKV2, KR, vcu, G);
    }
    GRID_SYNC();
    {
        pg8::Gemm g{CQ, Wq_t, MT, 1536, 256, 0}; pg8::StaticOrder S; S.init(MT, 1536, G, bx);
        pg8::EpiQ E{Qb, cosT, sinT};
        pg8::gemm_phase<pg8::EpiQ, false>(lds, g, S, E);
    }
    {
        pg8::Gemm g{CKV, Wuk_t, MT, 1024, 128, 0}; pg8::StaticOrder S; S.init(MT, 1024, G, bx);
        pg8::EpiStore E{KN, 1024, nullptr, nullptr};
        pg8::gemm_phase<pg8::EpiStore, false>(lds, g, S, E);
    }
    {
        pg8::Gemm g{Wuv_t, CKV2, 1024, MT, 128, 0}; pg8::StaticOrder S; S.init(1024, MT, G, bx);
        pg8::EpiStore E{VT, MT, nullptr, nullptr};
        pg8::gemm_phase<pg8::EpiStore, false>(lds, g, S, E);
    }
    GRID_SYNC();
    for (int U = vcu; U < NB * NH * 16; U += G) {
        const int bh = U >> 4, qb = U & 15;
        att::unit(lds, Qb, KN, KR, VT, Ob, bh >> 4, bh & 15, qb);
    }
    GRID_SYNC();
    {
        pg8::Gemm g{Ob, Wo_t, MT, DM, DM, 0}; pg8::StaticOrder S; S.init(MT, DM, G, bx);
        pg8::EpiStore E{Yb, DM, nullptr, nullptr};
        pg8::gemm_phase<pg8::EpiStore, false>(lds, g, S, E);
    }
    GRID_SYNC();
    rows_phase<true, true, true, true>(XB, XB2, Yb, NG(1, 3), MODP(1, 5), 1.0f, NG(1, 4), MODP(1, 6), MODP(1, 7), Hb, vcu, G);
    GRID_SYNC();
    FFN_PHASE(1, 1);
    rows_phase<true, false, true, false>(XB2, X, Yb, NG(1, 5), MODP(1, 8), 0.5f, nullptr, nullptr, nullptr, nullptr, vcu, G);
}

extern "C" void kernel_launch(void* const* d_in, const int* in_sizes, int n_in, void* d_out, int out_size, void* d_ws, size_t ws_size, hipStream_t stream) {
    static int grid = 0;
    if (grid == 0) {
        if (n_in != 17 || out_size != MT * DM || ws_size < WS_END) { fprintf(stderr, "kernel_launch: unexpected shapes (n_in %d out %d ws %zu)\n", n_in, out_size, ws_size); grid = -1; return; }
        int dev = 0, cus = 0, per_cu = 0;
        hipGetDevice(&dev);
        hipDeviceGetAttribute(&cus, hipDeviceAttributeMultiprocessorCount, dev);
        hipFuncSetAttribute((const void*)fwd_megakernel, hipFuncAttributeMaxDynamicSharedMemorySize, LDS_BYTES);
        hipOccupancyMaxActiveBlocksPerMultiprocessor(&per_cu, (const void*)fwd_megakernel, 512, LDS_BYTES);
        (void)hipGetLastError();
        if (per_cu < 1) { fprintf(stderr, "kernel_launch: occupancy query says %d blocks per CU\n", per_cu); per_cu = 1; }
        grid = cus;
    }
    if (grid < 0) return;
    if (hipMemsetAsync((char*)d_ws + WS_CTL, 0, 65536, stream) != hipSuccess) { fprintf(stderr, "kernel_launch: memset of control words failed\n"); return; }
    Args a{};
    for (int i = 0; i < 17; ++i) a.in[i] = (const float*)d_in[i];
    a.out = (float*)d_out; a.ws = (unsigned char*)d_ws;
    void* args[] = {&a};
    hipError_t e = hipLaunchCooperativeKernel((const void*)fwd_megakernel, dim3(grid), dim3(512), args, LDS_BYTES, stream);
    if (e != hipSuccess) fprintf(stderr, "cooperative launch failed: %s (grid %d)\n", hipGetErrorString(e), grid);
}
```

```cpp
#include <hip/hip_runtime.h>
#include <hip/hip_cooperative_groups.h>
#include <cstdio>
#include <cstdint>
namespace cg = cooperative_groups;

#define LAS __attribute__((address_space(3)))
typedef unsigned short bf16_t;
typedef short bf16x8 __attribute__((ext_vector_type(8)));
typedef short s16x4 __attribute__((ext_vector_type(4)));
typedef float f32x4 __attribute__((ext_vector_type(4)));
typedef float f32x16 __attribute__((ext_vector_type(16)));
typedef unsigned u32x4 __attribute__((ext_vector_type(4)));
typedef unsigned u32x2 __attribute__((ext_vector_type(2)));
typedef float f32x2_t __attribute__((ext_vector_type(2)));
typedef __bf16 bf16x2_t __attribute__((ext_vector_type(2)));
#define DI __device__ __forceinline__

DI unsigned cvtpk(float lo, float hi) { f32x2_t v = {lo, hi}; bf16x2_t b = __builtin_convertvector(v, bf16x2_t); return __builtin_bit_cast(unsigned, b); }
DI float bflo(unsigned u) { return __uint_as_float(u << 16); }
DI float bfhi(unsigned u) { return __uint_as_float(u & 0xffff0000u); }
DI int opaque_tid() { int t = threadIdx.x; asm volatile("" : "+v"(t)); return t; }
DI float wave_sum(float v) {
#pragma unroll
    for (int o = 1; o < 64; o <<= 1) v += __shfl_xor(v, o);
    return v;
}

constexpr int NB = 8, SEQ = 4096, DM = 1024, NH = 16, FF = 2816, MT = NB * SEQ;
constexpr float EPS = 1e-6f;
constexpr float QSCALE = 0.10206207261596577f * 1.4426950408889634f;
constexpr size_t MiB = 1u << 20;
constexpr size_t WS_CTL = 0, WS_MOD = 1 * MiB, WS_ROPE = 2 * MiB;
constexpr size_t W1_BYTES = (size_t)5632 * 1024 * 2, W2_BYTES = (size_t)1024 * 2816 * 2;
constexpr size_t WS_W1 = 8 * MiB;
constexpr size_t WS_W2 = WS_W1 + 4 * W1_BYTES;
constexpr size_t WS_WP = WS_W2 + 4 * W2_BYTES;
constexpr size_t WS_WLAT = WS_WP + 1024 * 256 * 2;
constexpr size_t WS_WQ = WS_WLAT + 512 * 1024 * 2;
constexpr size_t WS_WUK = WS_WQ + 1536 * 256 * 2;
constexpr size_t WS_WUV = WS_WUK + 1024 * 128 * 2;
constexpr size_t WS_WO = WS_WUV + 1024 * 128 * 2;
constexpr size_t WS_WEND = WS_WO + 1024 * 1024 * 2;
static_assert(WS_WEND <= 88 * MiB, "weights");
constexpr size_t WS_H = 88 * MiB, WS_Y = 152 * MiB, WS_ACT = 216 * MiB;
constexpr size_t WS_LAT = 216 * MiB, WS_CQ = 280 * MiB, WS_CKV = 296 * MiB, WS_KR = 304 * MiB, WS_Q = 306 * MiB, WS_KN = 402 * MiB;
constexpr size_t WS_CKV2 = 466 * MiB;
constexpr size_t WS_VT = WS_H, WS_O = WS_LAT, WS_PD = WS_ACT, WS_END = 474 * MiB;
constexpr int RING_BYTES = 135168, LDS_BYTES = RING_BYTES + 256;
constexpr int CW_BAR = 1024;

namespace pg8 {
constexpr int BM = 256, BK = 64, HALF = 128, HTB = HALF * BK * 2, NXCD = 8, WGM = 8;
DI int lds_byte(int r, int c) { const int st = (r >> 4) * 2 + (c >> 5), rr = r & 15, cc = c & 31, ob = rr * 64 + cc * 2; return st * 1024 + (ob ^ (((ob >> 9) & 1) << 5)); }
DI void stage_rc(int b, int& R, int& C) { const int st = b / 1024, sb = b % 1024, swz = sb ^ (((sb >> 9) & 1) << 5); R = (st >> 1) * 16 + swz / 64; C = (st & 1) * 32 + (swz % 64) / 2; }
DI int perm32(int rho) { const int n = rho >> 4, i = rho & 15; return 8 * (i >> 2) + 4 * n + (i & 3); }
struct Unit { int pm, pn; };
struct Gemm { const bf16_t* A; const bf16_t* Bt; int M, N, K; size_t a_pn_stride; };
struct StaticOrder {
    int nM, nN, nwg, G, c;
    DI void init(int M, int N, int G_, int c_) { nM = M / BM; nN = N / BM; nwg = nM * nN; G = G_; c = c_; }
    DI bool next(int i, Unit& u) const {
        const long L = (long)i * G + c; if (L >= nwg) return false;
        int wgid = (int)L; { const int q = nwg / NXCD, r = nwg % NXCD, xcd = wgid % NXCD, off = wgid / NXCD; wgid = (xcd < r ? xcd * (q + 1) : r * (q + 1) + (xcd - r) * q) + off; }
        const int nig = WGM * nN, gid = wgid / nig, fm = gid * WGM, gsz = (nM - fm) < WGM ? (nM - fm) : WGM;
        u.pm = fm + ((wgid % nig) % gsz); u.pn = (wgid % nig) / gsz; return true;
    }
};

struct EpiStore {
    static constexpr bool AFTER_DRAIN = false;
    bf16_t* O; int ldc; const float* bias; const float* cs;
    DI void operator()(const f32x4 (&acc)[2][2][4][2], const Unit& u, int wr, int wc, int fr, int fq) const {
        const int row0 = u.pm * BM + wr * 64 + fr, col0 = u.pn * BM + wc * 32 + 8 * fq;
        f32x4 bv[2][2], sv[2][2];
#pragma unroll
        for (int bj = 0; bj < 2; ++bj)
#pragma unroll
            for (int n = 0; n < 2; ++n) {
                bv[bj][n] = bias ? *(const f32x4*)(bias + col0 + bj * HALF + 4 * n) : (f32x4){0.f, 0.f, 0.f, 0.f};
                sv[bj][n] = cs ? *(const f32x4*)(cs + col0 + bj * HALF + 4 * n) : (f32x4){1.f, 1.f, 1.f, 1.f};
            }
#pragma unroll
        for (int ai = 0; ai < 2; ++ai)
#pragma unroll
            for (int m = 0; m < 4; ++m) {
                bf16_t* rowp = O + (size_t)(row0 + ai * HALF + m * 16) * ldc + col0;
#pragma unroll
                for (int bj = 0; bj < 2; ++bj) {
                    const f32x4 v0 = (acc[ai][bj][m][0] + bv[bj][0]) * sv[bj][0], v1 = (acc[ai][bj][m][1] + bv[bj][1]) * sv[bj][1];
                    u32x4 w; w.x = cvtpk(v0[0], v0[1]); w.y = cvtpk(v0[2], v0[3]); w.z = cvtpk(v1[0], v1[1]); w.w = cvtpk(v1[2], v1[3]);
                    *(u32x4*)(rowp + bj * HALF) = w;
                }
            }
    }
};
struct EpiF32 {
    static constexpr bool AFTER_DRAIN = false;
    float* O; int ldc;
    DI void operator()(const f32x4 (&acc)[2][2][4][2], const Unit& u, int wr, int wc, int fr, int fq) const {
        const int row0 = u.pm * BM + wr * 64 + fr, col0 = u.pn * BM + wc * 32 + 8 * fq;
#pragma unroll
        for (int ai = 0; ai < 2; ++ai)
#pragma unroll
            for (int m = 0; m < 4; ++m) {
                float* rowp = O + (size_t)(row0 + ai * HALF + m * 16) * ldc + col0;
#pragma unroll
                for (int bj = 0; bj < 2; ++bj) { *(f32x4*)(rowp + bj * HALF) = acc[ai][bj][m][0]; *(f32x4*)(rowp + bj * HALF + 4) = acc[ai][bj][m][1]; }
            }
    }
};
struct EpiSwiglu {
    static constexpr bool AFTER_DRAIN = false;
    bf16_t* O; int ldc;
    DI void operator()(const f32x4 (&acc)[2][2][4][2], const Unit& u, int wr, int wc, int fr, int fq) const {
        const int row0 = u.pm * BM + wr * 64 + fr, col0 = u.pn * HALF + wc * 32 + 8 * fq;
#pragma unroll
        for (int ai = 0; ai < 2; ++ai)
#pragma unroll
            for (int m = 0; m < 4; ++m) {
                float a[8];
#pragma unroll
                for (int n = 0; n < 2; ++n)
#pragma unroll
                    for (int e = 0; e < 4; ++e) {
                        const float g = acc[ai][0][m][n][e], up = acc[ai][1][m][n][e];
                        const float sg = __builtin_amdgcn_rcpf(1.0f + __builtin_amdgcn_exp2f(-1.4426950408889634f * g));
                        a[4 * n + e] = g * sg * up;
                    }
                u32x4 w; w.x = cvtpk(a[0], a[1]); w.y = cvtpk(a[2], a[3]); w.z = cvtpk(a[4], a[5]); w.w = cvtpk(a[6], a[7]);
                *(u32x4*)(O + (size_t)(row0 + ai * HALF + m * 16) * ldc + col0) = w;
            }
    }
};
struct EpiQ {
    static constexpr bool AFTER_DRAIN = false;
    bf16_t* O; const float* cosT; const float* sinT;
    DI void operator()(const f32x4 (&acc)[2][2][4][2], const Unit& u, int wr, int wc, int fr, int fq) const {
        const int row0 = u.pm * BM + wr * 64 + fr, col0 = u.pn * BM + wc * 32 + 8 * fq;
#pragma unroll
        for (int ai = 0; ai < 2; ++ai)
#pragma unroll
            for (int m = 0; m < 4; ++m) {
                const int row = row0 + ai * HALF + m * 16, s = row & (SEQ - 1);
#pragma unroll
                for (int bj = 0; bj < 2; ++bj) {
                    const int col = col0 + bj * HALF, hc = col % 96;
                    f32x4 v0 = acc[ai][bj][m][0], v1 = acc[ai][bj][m][1];
                    if (hc >= 64) {
                        const int j0 = (hc - 64) >> 1;
                        const f32x4 cs = *(const f32x4*)(cosT + s * 16 + j0), sn = *(const f32x4*)(sinT + s * 16 + j0);
                        const f32x4 t0 = v0, t1 = v1;
                        v0[0] = t0[0] * cs[0] - t0[1] * sn[0]; v0[1] = t0[1] * cs[0] + t0[0] * sn[0];
                        v0[2] = t0[2] * cs[1] - t0[3] * sn[1]; v0[3] = t0[3] * cs[1] + t0[2] * sn[1];
                        v1[0] = t1[0] * cs[2] - t1[1] * sn[2]; v1[1] = t1[1] * cs[2] + t1[0] * sn[2];
                        v1[2] = t1[2] * cs[3] - t1[3] * sn[3]; v1[3] = t1[3] * cs[3] + t1[2] * sn[3];
                    }
                    v0 = v0 * QSCALE; v1 = v1 * QSCALE;
                    u32x4 w; w.x = cvtpk(v0[0], v0[1]); w.y = cvtpk(v0[2], v0[3]); w.z = cvtpk(v1[0], v1[1]); w.w = cvtpk(v1[2], v1[3]);
                    *(u32x4*)(O + (size_t)row * 1536 + col) = w;
                }
            }
    }
};

struct EpiLat {
    static constexpr bool AFTER_DRAIN = true;
    const float* qn; const float* kvn; const float* cosT; const float* sinT; bf16_t* CQ; bf16_t* CKV; bf16_t* CKV2; bf16_t* KR;
    DI void operator()(const f32x4 (&)[2][2][4][2], const Unit&, int, int, int, int) const {}
    DI void fused(const f32x4 (&acc)[2][2][4][2], const Unit& u, int wr, int wc, int fr, int fq, LAS unsigned char* lds) const {
        LAS float* P = (LAS float*)lds;
        const bool isq = (u.pn == 0);
#pragma unroll
        for (int ai = 0; ai < 2; ++ai)
#pragma unroll
            for (int m = 0; m < 4; ++m) {
                float s = 0.f;
#pragma unroll
                for (int n = 0; n < 2; ++n) { const f32x4 v = acc[ai][0][m][n]; s += (v[0] * v[0] + v[1] * v[1]) + (v[2] * v[2] + v[3] * v[3]); }
                if (isq) {
#pragma unroll
                    for (int n = 0; n < 2; ++n) { const f32x4 v = acc[ai][1][m][n]; s += (v[0] * v[0] + v[1] * v[1]) + (v[2] * v[2] + v[3] * v[3]); }
                }
                s += __shfl_xor(s, 16); s += __shfl_xor(s, 32);
                if (fq == 0) P[(ai * HALF + wr * 64 + m * 16 + fr) * 4 + wc] = s;
            }
        asm volatile("s_waitcnt lgkmcnt(0)" ::: "memory"); __builtin_amdgcn_s_barrier(); asm volatile("" ::: "memory");
        const float invn = isq ? (1.0f / 256) : (1.0f / 128);
        const int col0 = wc * 32 + 8 * fq;
#pragma unroll
        for (int ai = 0; ai < 2; ++ai)
#pragma unroll
            for (int m = 0; m < 4; ++m) {
                const int rl = ai * HALF + wr * 64 + m * 16 + fr, row = u.pm * BM + rl;
                const f32x4 pp = *(const LAS f32x4*)(P + rl * 4);
                const float rstd = 1.0f / sqrtf(((pp[0] + pp[1]) + (pp[2] + pp[3])) * invn + EPS);
                if (isq) {
#pragma unroll
                    for (int bj = 0; bj < 2; ++bj) {
                        const int col = col0 + bj * HALF;
                        const f32x4 g0 = *(const f32x4*)(qn + col), g1 = *(const f32x4*)(qn + col + 4);
                        const f32x4 v0 = (acc[ai][bj][m][0] * rstd) * g0, v1 = (acc[ai][bj][m][1] * rstd) * g1;
                        u32x4 w; w.x = cvtpk(v0[0], v0[1]); w.y = cvtpk(v0[2], v0[3]); w.z = cvtpk(v1[0], v1[1]); w.w = cvtpk(v1[2], v1[3]);
                        *(u32x4*)(CQ + (size_t)row * 256 + col) = w;
                    }
                } else {
                    {
                        const f32x4 g0 = *(const f32x4*)(kvn + col0), g1 = *(const f32x4*)(kvn + col0 + 4);
                        const f32x4 v0 = (acc[ai][0][m][0] * rstd) * g0, v1 = (acc[ai][0][m][1] * rstd) * g1;
                        u32x4 w; w.x = cvtpk(v0[0], v0[1]); w.y = cvtpk(v0[2], v0[3]); w.z = cvtpk(v1[0], v1[1]); w.w = cvtpk(v1[2], v1[3]);
                        *(u32x4*)(CKV + (size_t)row * 128 + col0) = w;
                        const int j = row & 15, prow = (row & ~15) + ((j >= 4 && j < 8) ? j + 4 : ((j >= 8 && j < 12) ? j - 4 : j));
                        *(u32x4*)(CKV2 + (size_t)prow * 128 + col0) = w;
                    }
                    if (wc == 0) {
                        const int s = row & (SEQ - 1);
                        const f32x4 cs = *(const f32x4*)(cosT + s * 16 + 4 * fq), sn = *(const f32x4*)(sinT + s * 16 + 4 * fq);
                        const f32x4 t0 = acc[ai][1][m][0], t1 = acc[ai][1][m][1];
                        u32x4 w;
                        w.x = cvtpk(t0[0] * cs[0] - t0[1] * sn[0], t0[1] * cs[0] + t0[0] * sn[0]);
                        w.y = cvtpk(t0[2] * cs[1] - t0[3] * sn[1], t0[3] * cs[1] + t0[2] * sn[1]);
                        w.z = cvtpk(t1[0] * cs[2] - t1[1] * sn[2], t1[1] * cs[2] + t1[0] * sn[2]);
                        w.w = cvtpk(t1[2] * cs[3] - t1[3] * sn[3], t1[3] * cs[3] + t1[2] * sn[3]);
                        *(u32x4*)(KR + (size_t)row * 32 + 8 * fq) = w;
                    }
                }
            }
        asm volatile("s_waitcnt lgkmcnt(0)" ::: "memory"); __builtin_amdgcn_s_barrier(); asm volatile("" ::: "memory");
    }
};

template <class Epi, bool ALIGN_EPI = true>
DI void gemm_phase(LAS unsigned char* lds, const Gemm g, const StaticOrder& S, const Epi& E) {
    int tid_ = threadIdx.x; asm volatile("" : "+v"(tid_));
    const int tid = tid_, wid = __builtin_amdgcn_readfirstlane(tid >> 6), lane = tid & 63, wr = wid >> 2, wc = wid & 3, fr = lane & 15, fq = lane >> 4;
    const int K = g.K, nt = K / BK;
    unsigned voffA[2], voffB[2];
#pragma unroll
    for (int i = 0; i < 2; ++i) { int R, C; stage_rc(tid * 16 + i * 8192, R, C); const int Rb = (R & ~31) + perm32(R & 31);
        voffA[i] = (unsigned)(R * K + C) * 2u; voffB[i] = (unsigned)(Rb * K + C) * 2u; }
    const size_t kstep = (size_t)(BK * 2);
    const size_t hstep = (size_t)HALF * K * 2;
    const size_t tstep = 2 * hstep;
    const unsigned ldsw = (unsigned)wid * 1024u;
    const int aoff = lds_byte(wr * 64 + fr, fq * 8), boff = lds_byte(wc * 32 + fr, fq * 8);
#define PG8_SA(b, h) (((b) * 2 + (h)) * HTB)
#define PG8_SB(b, h) ((4 + (b) * 2 + (h)) * HTB)
#define PG8_STAGE(bufoff, gbase, voff) do { _Pragma("unroll") for (int _i = 0; _i < 2; ++_i) { \
        unsigned vo_ = (voff)[_i]; asm volatile("" : "+v"(vo_));     \
        __builtin_amdgcn_global_load_lds((const unsigned*)((const char*)(gbase) + vo_), (LAS unsigned*)(lds + (bufoff) + ldsw + _i * 8192), 16, 0, 0); } } while (0)
#define PG8_LDA(dst, b, h) do { _Pragma("unroll") for (int m = 0; m < 4; ++m) _Pragma("unroll") for (int k = 0; k < 2; ++k) dst[m][k] = *(const LAS bf16x8*)(lds + PG8_SA(b, h) + aoff + m * 2048 + k * 1024); } while (0)
#define PG8_LDB(dst, b, h) do { _Pragma("unroll") for (int n = 0; n < 2; ++n) _Pragma("unroll") for (int k = 0; k < 2; ++k) dst[n][k] = *(const LAS bf16x8*)(lds + PG8_SB(b, h) + boff + n * 2048 + k * 1024); } while (0)
#define PG8_MMA(ai, bj, At, Bt) do { __builtin_amdgcn_s_setprio(1); _Pragma("unroll") for (int m = 0; m < 4; ++m) _Pragma("unroll") for (int n = 0; n < 2; ++n) _Pragma("unroll") for (int k = 0; k < 2; ++k) \
        acc[ai][bj][m][n] = __builtin_amdgcn_mfma_f32_16x16x32_bf16(Bt[n][k], At[m][k], acc[ai][bj][m][n], 0, 0, 0); __builtin_amdgcn_s_setprio(0); } while (0)
#define PG8_WAIT_V(n) asm volatile("s_waitcnt vmcnt(" #n ")" ::: "memory")
#define PG8_WAIT_L(n) asm volatile("s_waitcnt lgkmcnt(" #n ")" ::: "memory")
#define PG8_BAR __builtin_amdgcn_s_barrier()
#define PG8_SCHED __builtin_amdgcn_sched_barrier(0)
    Unit cur, nxt; int ui = 0;
    if (!S.next(0, cur)) return;
    f32x4 acc[2][2][4][2];
#pragma unroll
    for (int a = 0; a < 2; ++a)
#pragma unroll
        for (int b = 0; b < 2; ++b)
#pragma unroll
            for (int m = 0; m < 4; ++m)
#pragma unroll
                for (int n = 0; n < 2; ++n) acc[a][b][m][n] = (f32x4){0.f, 0.f, 0.f, 0.f};
    bf16x8 At[4][2], B0[2][2], B1[2][2];
    const char* cA = (const char*)g.A + (size_t)cur.pm * tstep + (size_t)cur.pn * g.a_pn_stride; const char* cB = (const char*)g.Bt + (size_t)cur.pn * tstep;
    PG8_STAGE(PG8_SB(0, 0), cB, voffB); PG8_STAGE(PG8_SB(0, 1), cB + hstep, voffB); PG8_STAGE(PG8_SA(0, 0), cA, voffA); PG8_STAGE(PG8_SA(0, 1), cA + hstep, voffA);
    if (wr == 1) PG8_BAR;
    PG8_WAIT_V(2); PG8_BAR;
    PG8_STAGE(PG8_SB(1, 0), cB + kstep, voffB); PG8_STAGE(PG8_SA(1, 0), cA + kstep, voffA); PG8_STAGE(PG8_SB(1, 1), cB + hstep + kstep, voffB);
    PG8_WAIT_V(6); PG8_BAR;
    for (;;) {
        const bool has_next = S.next(ui + 1, nxt);
        const char* nA = has_next ? (const char*)g.A + (size_t)nxt.pm * tstep + (size_t)nxt.pn * g.a_pn_stride : cA; const char* nB = has_next ? (const char*)g.Bt + (size_t)nxt.pn * tstep : cB;
        for (int t = 0; t < nt; t += 2) {
            const bool last = (t == nt - 2);
            const char* a1 = cA + (size_t)(t + 1) * kstep;
            const char* a2 = last ? nA : cA + (size_t)(t + 2) * kstep; const char* b2 = last ? nB : cB + (size_t)(t + 2) * kstep;
            const char* a3 = a2 + kstep; const char* b3 = b2 + kstep;
            PG8_LDB(B0, 0, 0); PG8_LDB(B1, 0, 1); PG8_SCHED; PG8_LDA(At, 0, 0); PG8_STAGE(PG8_SA(1, 1), a1 + hstep, voffA);
            PG8_WAIT_V(8); PG8_WAIT_L(0); PG8_BAR; PG8_MMA(0, 0, At, B0); PG8_MMA(0, 1, At, B1); PG8_BAR; PG8_SCHED;
            PG8_LDA(At, 0, 1); PG8_STAGE(PG8_SB(0, 0), b2, voffB); PG8_STAGE(PG8_SB(0, 1), b2 + hstep, voffB); PG8_STAGE(PG8_SA(0, 0), a2, voffA);
            PG8_WAIT_V(8); PG8_WAIT_L(0); PG8_BAR; PG8_MMA(1, 0, At, B0); PG8_MMA(1, 1, At, B1); PG8_BAR; PG8_SCHED;
            PG8_LDB(B0, 1, 0); PG8_LDB(B1, 1, 1); PG8_SCHED; PG8_LDA(At, 1, 0); PG8_STAGE(PG8_SA(0, 1), a2 + hstep, voffA);
            PG8_WAIT_V(8); PG8_WAIT_L(0); PG8_BAR; PG8_MMA(0, 0, At, B0); PG8_MMA(0, 1, At, B1); PG8_BAR; PG8_SCHED;
            PG8_LDA(At, 1, 1); PG8_STAGE(PG8_SB(1, 0), b3, voffB); PG8_STAGE(PG8_SB(1, 1), b3 + hstep, voffB); PG8_STAGE(PG8_SA(1, 0), a3, voffA);
            PG8_WAIT_V(8); PG8_WAIT_L(0); PG8_BAR; PG8_MMA(1, 0, At, B0); PG8_MMA(1, 1, At, B1); PG8_BAR; PG8_SCHED;
        }
        if constexpr (ALIGN_EPI) { if (wr == 0) PG8_BAR; }
        if constexpr (!Epi::AFTER_DRAIN) E(acc, cur, wr, wc, fr, fq);
        if (!has_next) break;
#pragma unroll
        for (int a = 0; a < 2; ++a)
#pragma unroll
            for (int b = 0; b < 2; ++b)
#pragma unroll
                for (int m = 0; m < 4; ++m)
#pragma unroll
                    for (int n = 0; n < 2; ++n) acc[a][b][m][n] = (f32x4){0.f, 0.f, 0.f, 0.f};
        cur = nxt; cA = nA; cB = nB; ++ui;
        if constexpr (ALIGN_EPI) { if (wr == 1) PG8_BAR; }
    }
    PG8_WAIT_V(0);
    if constexpr (!ALIGN_EPI) { if (wr == 0) PG8_BAR; }
    PG8_BAR;
    if constexpr (Epi::AFTER_DRAIN) E.fused(acc, cur, wr, wc, fr, fq, lds);
#undef PG8_SA
#undef PG8_SB
#undef PG8_STAGE
#undef PG8_LDA
#undef PG8_LDB
#undef PG8_MMA
#undef PG8_WAIT_V
#undef PG8_WAIT_L
#undef PG8_BAR
#undef PG8_SCHED
}
}

DI int rowmap(int mode, int n) {
    if (mode == 1) { const int up = n >= FF ? 1 : 0, j = n - up * FF; return (j >> 7) * 256 + up * 128 + (j & 127); }
    if (mode == 2) { const int h = n / 96, d = n - h * 96; if (d < 64) return n; if (d < 80) return h * 96 + 64 + 2 * (d - 64); return h * 96 + 64 + 2 * (d - 80) + 1; }
    if (mode == 3) { if (n < 384) return n; if (n < 400) return 384 + 2 * (n - 384); return 384 + 2 * (n - 400) + 1; }
    return n;
}
DI void transpose_item(const float* W, int K, int N, bf16_t* WT, int mode, int row_off, LAS float* scr, int item, int lane) {
    const int nblk = N / 32, kb = item / nblk, nb = item - kb * nblk, k0 = 64 * kb, n0 = 32 * nb;
#pragma unroll 8
    for (int i = 0; i < 32; ++i) { const int kk = 2 * i + (lane >> 5); scr[kk * 33 + (lane & 31)] = __builtin_nontemporal_load(&W[(size_t)(k0 + kk) * N + n0 + (lane & 31)]); }
    asm volatile("s_waitcnt lgkmcnt(0)" ::: "memory");
    const int c = lane & 7;
#pragma unroll
    for (int j = 0; j < 4; ++j) { const int n = (lane >> 3) + 8 * j; const LAS float* s = scr + (8 * c) * 33 + n;
        u32x4 o; o.x = cvtpk(s[0 * 33], s[1 * 33]); o.y = cvtpk(s[2 * 33], s[3 * 33]); o.z = cvtpk(s[4 * 33], s[5 * 33]); o.w = cvtpk(s[6 * 33], s[7 * 33]);
        *(u32x4*)(WT + (size_t)(row_off + rowmap(mode, n0 + n)) * K + k0 + 8 * c) = o; }
    asm volatile("s_waitcnt lgkmcnt(0)" ::: "memory");
}
DI void ada_item(const float* ada_w, const float* ada_b, float* mod, const LAS float* sc, int item, int lane) {
    const int l = item / 288, n0 = (item - l * 288) * 32, cgp = lane & 7, kr = lane >> 3;
    const float* W = ada_w + (size_t)l * 1024 * 9216 + n0 + 4 * cgp;
    float acc[8][4];
#pragma unroll
    for (int b = 0; b < 8; ++b)
#pragma unroll
        for (int e = 0; e < 4; ++e) acc[b][e] = 0.f;
    for (int k = kr; k < 1024; k += 64) {
        f32x4 w[8];
#pragma unroll
        for (int u = 0; u < 8; ++u) w[u] = __builtin_nontemporal_load((const f32x4*)(W + (size_t)(k + 8 * u) * 9216));
#pragma unroll
        for (int u = 0; u < 8; ++u) {
            const f32x4 s0 = *(const LAS f32x4*)(sc + (k + 8 * u) * 8), s1 = *(const LAS f32x4*)(sc + (k + 8 * u) * 8 + 4);
#pragma unroll
            for (int e = 0; e < 4; ++e) {
                acc[0][e] += s0[0] * w[u][e]; acc[1][e] += s0[1] * w[u][e]; acc[2][e] += s0[2] * w[u][e]; acc[3][e] += s0[3] * w[u][e];
                acc[4][e] += s1[0] * w[u][e]; acc[5][e] += s1[1] * w[u][e]; acc[6][e] += s1[2] * w[u][e]; acc[7][e] += s1[3] * w[u][e];
            }
        }
    }
#pragma unroll
    for (int b = 0; b < 8; ++b)
#pragma unroll
        for (int e = 0; e < 4; ++e) { float v = acc[b][e]; v += __shfl_xor(v, 8); v += __shfl_xor(v, 16); v += __shfl_xor(v, 32); acc[b][e] = v; }
    if (kr == 0) {
        const f32x4 bias = *(const f32x4*)(ada_b + l * 9216 + n0 + 4 * cgp);
#pragma unroll
        for (int b = 0; b < 8; ++b) { f32x4 o = {acc[b][0] + bias[0], acc[b][1] + bias[1], acc[b][2] + bias[2], acc[b][3] + bias[3]}; *(f32x4*)(mod + (size_t)(l * 8 + b) * 9216 + n0 + 4 * cgp) = o; }
    }
}
DI void rope_entry(float* cosT, float* sinT, int idx) {
    const int s = idx >> 4, j = idx & 15, jq = j & 3;
    double pw = jq == 0 ? 1.0 : (jq == 1 ? 1.7782794100389228 : (jq == 2 ? 3.1622776601683795 : 5.623413251903491));
    const int dec = j >> 2; pw *= dec == 0 ? 1.0 : (dec == 1 ? 10.0 : (dec == 2 ? 100.0 : 1000.0));
    const float inv = 1.0f / (float)pw;
    const float ang = (float)s * inv;
    const double a = (double)ang;
    const double kq = __builtin_rint(a * 0.63661977236758134308);
    const double t = (a - kq * 1.5707963267948966192) - kq * 6.123233995736766036e-17;
    const double t2 = t * t;
    const double sn = t * (1.0 + t2 * (-1.0 / 6 + t2 * (1.0 / 120 + t2 * (-1.0 / 5040 + t2 * (1.0 / 362880 + t2 * (-1.0 / 39916800 + t2 * (1.0 / 6227020800.0)))))));
    const double cs = 1.0 + t2 * (-0.5 + t2 * (1.0 / 24 + t2 * (-1.0 / 720 + t2 * (1.0 / 40320 + t2 * (-1.0 / 3628800 + t2 * (1.0 / 479001600.0))))));
    const int q = (int)((long long)kq & 3);
    const double c = q == 0 ? cs : (q == 1 ? -sn : (q == 2 ? -cs : sn));
    const double sv = q == 0 ? sn : (q == 1 ? cs : (q == 2 ? -sn : -cs));
    cosT[idx] = (float)c; sinT[idx] = (float)sv;
}

template <bool POST, bool PRE, bool STOREX, bool XIB, bool XOB>
DI void rows_range(const void* xin, void* xout, const bf16_t* Y, const float* gpost, const float* gate, float w,
                   const float* gpre, const float* shift, const float* scale, bf16_t* Hout, int row0, int rpw, int lane) {
    const int b = row0 >> 12;
    f32x4 ca[4], cb[4], cs[4];
#pragma unroll
    for (int j = 0; j < 4; ++j) {
        if (POST) { const f32x4 gp = ((const f32x4*)gpost)[lane + 64 * j], gt = ((const f32x4*)(gate + (size_t)b * 9216))[lane + 64 * j]; ca[j] = (w * (1.0f + gt)) * gp; }
        if (PRE) { const f32x4 gp = ((const f32x4*)gpre)[lane + 64 * j], sc = ((const f32x4*)(scale + (size_t)b * 9216))[lane + 64 * j]; cb[j] = gp * (1.0f + sc); cs[j] = ((const f32x4*)(shift + (size_t)b * 9216))[lane + 64 * j]; }
    }
    for (int r = 0; r < rpw; r += 2) {
        f32x4 x[2][4]; u32x2 yb[2][4];
#pragma unroll
        for (int q = 0; q < 2; ++q) {
            const int row = row0 + r + q;
            if (XIB) { const u32x2* xr = (const u32x2*)((const bf16_t*)xin + (size_t)row * DM) + lane;
#pragma unroll
                for (int j = 0; j < 4; ++j) { const u32x2 t = __builtin_nontemporal_load(&xr[64 * j]); x[q][j] = (f32x4){bflo(t.x), bfhi(t.x), bflo(t.y), bfhi(t.y)}; } }
            else { const f32x4* xr = (const f32x4*)((const float*)xin + (size_t)row * DM) + lane;
#pragma unroll
                for (int j = 0; j < 4; ++j) x[q][j] = __builtin_nontemporal_load(&xr[64 * j]); }
            if (POST) { const u32x2* yr = (const u32x2*)(Y + (size_t)row * DM) + lane;
#pragma unroll
                for (int j = 0; j < 4; ++j) yb[q][j] = __builtin_nontemporal_load(&yr[64 * j]); }
        }
#pragma unroll
        for (int q = 0; q < 2; ++q) {
            const int row = row0 + r + q;
            if (POST) {
                f32x4 y[4]; float ss = 0.f;
#pragma unroll
                for (int j = 0; j < 4; ++j) { const u32x2 t = yb[q][j]; y[j] = (f32x4){bflo(t.x), bfhi(t.x), bflo(t.y), bfhi(t.y)}; ss += (y[j][0] * y[j][0] + y[j][1] * y[j][1]) + (y[j][2] * y[j][2] + y[j][3] * y[j][3]); }
                const float rstd = 1.0f / sqrtf(wave_sum(ss) * (1.0f / DM) + EPS);
#pragma unroll
                for (int j = 0; j < 4; ++j) x[q][j] = x[q][j] + ca[j] * (y[j] * rstd);
                if (STOREX) {
                    if (XOB) { u32x2* xo = (u32x2*)((bf16_t*)xout + (size_t)row * DM) + lane;
#pragma unroll
                        for (int j = 0; j < 4; ++j) { u32x2 o; o.x = cvtpk(x[q][j][0], x[q][j][1]); o.y = cvtpk(x[q][j][2], x[q][j][3]); xo[64 * j] = o; } }
                    else { f32x4* xo = (f32x4*)((float*)xout + (size_t)row * DM) + lane;
#pragma unroll
                        for (int j = 0; j < 4; ++j) xo[64 * j] = x[q][j]; }
                }
            }
            if (PRE) {
                float ss = 0.f;
#pragma unroll
                for (int j = 0; j < 4; ++j) ss += (x[q][j][0] * x[q][j][0] + x[q][j][1] * x[q][j][1]) + (x[q][j][2] * x[q][j][2] + x[q][j][3] * x[q][j][3]);
                const float rstd = 1.0f / sqrtf(wave_sum(ss) * (1.0f / DM) + EPS);
                u32x2* ho = (u32x2*)(Hout + (size_t)row * DM) + lane;
#pragma unroll
                for (int j = 0; j < 4; ++j) { const f32x4 h = (x[q][j] * rstd) * cb[j] + cs[j]; u32x2 o; o.x = cvtpk(h[0], h[1]); o.y = cvtpk(h[2], h[3]); ho[64 * j] = o; }
            }
        }
    }
}
template <bool POST, bool PRE, bool XIB, bool XOB>
DI void rows_phase(const void* xin, void* xout, const bf16_t* Y, const float* gpost, const float* gate, float w,
                   const float* gpre, const float* shift, const float* scale, bf16_t* Hout, int vcu, int G) {
    const int tid = opaque_tid(), lane = tid & 63, gw = vcu * 8 + __builtin_amdgcn_readfirstlane(tid >> 6), ngw = G * 8, rpw = MT / ngw;
    rows_range<POST, PRE, true, XIB, XOB>(xin, xout, Y, gpost, gate, w, gpre, shift, scale, Hout, gw * rpw, rpw, lane);
}
DI void lat_rows_phase(const float* LAT, const float* qn, const float* kvn, const float* cosT, const float* sinT, bf16_t* CQ, bf16_t* CKV, bf16_t* CKV2, bf16_t* KR, int vcu, int G) {
    const int tid = opaque_tid(), lane = tid & 63, gw = vcu * 8 + __builtin_amdgcn_readfirstlane(tid >> 6), ngw = G * 8;
    for (int row = gw; row < MT; row += ngw) {
        const float* lr = LAT + (size_t)row * 512;
        const f32x4 q = ((const f32x4*)lr)[lane];
        const f32x4 kv = ((const f32x4*)(lr + 256))[lane & 31];
        float sq = (q[0] * q[0] + q[1] * q[1]) + (q[2] * q[2] + q[3] * q[3]);
        float sk = (kv[0] * kv[0] + kv[1] * kv[1]) + (kv[2] * kv[2] + kv[3] * kv[3]);
        sq = wave_sum(sq);
#pragma unroll
        for (int o = 1; o < 32; o <<= 1) sk += __shfl_xor(sk, o);
        const float rq = 1.0f / sqrtf(sq * (1.0f / 256) + EPS), rk = 1.0f / sqrtf(sk * (1.0f / 128) + EPS);
        const f32x4 gq = ((const f32x4*)qn)[lane], gk = ((const f32x4*)kvn)[lane & 31];
        const f32x4 cq = (q * rq) * gq, ck = (kv * rk) * gk;
        u32x2 o; o.x = cvtpk(cq[0], cq[1]); o.y = cvtpk(cq[2], cq[3]); ((u32x2*)(CQ + (size_t)row * 256))[lane] = o;
        if (lane < 32) { u32x2 p; p.x = cvtpk(ck[0], ck[1]); p.y = cvtpk(ck[2], ck[3]); ((u32x2*)(CKV + (size_t)row * 128))[lane] = p;
            const int j = row & 15, prow = (row & ~15) + ((j >= 4 && j < 8) ? j + 4 : ((j >= 8 && j < 12) ? j - 4 : j));
            ((u32x2*)(CKV2 + (size_t)prow * 128))[lane] = p; }
        if (lane < 16) {
            const int s = row & (SEQ - 1);
            const float x1 = lr[384 + 2 * lane], x2 = lr[385 + 2 * lane], cs = cosT[s * 16 + lane], sn = sinT[s * 16 + lane];
            ((unsigned*)(KR + (size_t)row * 32))[lane] = cvtpk(x1 * cs - x2 * sn, x2 * cs + x1 * sn);
        }
    }
}
template <int W>
DI void pool_chunk(const bf16_t* H, bf16_t* PD, int b, int t0, int tid) {
    constexpr int HW = W / 2, NR = 32 + W - 1;
    const unsigned* src = (const unsigned*)(H + (size_t)b * SEQ * DM) + tid;
    float lo[NR], hi[NR];
#pragma unroll
    for (int i = 0; i < NR; ++i) { const int t = t0 - HW + i; unsigned v = 0u; if (t >= 0 && t < SEQ) v = src[(size_t)t * 512]; lo[i] = bflo(v); hi[i] = bfhi(v); }
    const int g = tid >> 7, c2 = tid & 127;
    unsigned* dst = (unsigned*)(PD + ((size_t)g * MT + (size_t)b * SEQ) * 256) + c2;
#pragma unroll
    for (int i = 0; i < 32; ++i) {
        const int t = t0 + i; int l0 = t - HW, h0 = t + HW; l0 = l0 < 0 ? 0 : l0; h0 = h0 > SEQ ? SEQ : h0;
        float sl = 0.f, sh = 0.f;
#pragma unroll
        for (int k = 0; k < W; ++k) { sl += lo[i + k]; sh += hi[i + k]; }
        const float inv = 1.0f / (float)(h0 - l0);
        dst[(size_t)t * 128] = cvtpk(sl * inv - lo[i + HW], sh * inv - hi[i + HW]);
    }
}

namespace att {
constexpr int KROW = 208, VROW = 144, KBUF = 64 * KROW, VBUF = 64 * VROW;
constexpr float THR = 8.0f;
#define SBAR() __builtin_amdgcn_sched_barrier(0)
#define MFMA32(a, b, c) __builtin_amdgcn_mfma_f32_32x32x16_bf16((a), (b), (c), 0, 0, 0)
DI float xhalf_max(float m) { auto rr = __builtin_amdgcn_permlane32_swap(__float_as_uint(m), __float_as_uint(m), false, false); return fmaxf(__uint_as_float(rr[0]), __uint_as_float(rr[1])); }
DI float xhalf_sum(float m) { auto rr = __builtin_amdgcn_permlane32_swap(__float_as_uint(m), __float_as_uint(m), false, false); return __uint_as_float(rr[0]) + __uint_as_float(rr[1]); }
template <int G> DI void valu_a(const f32x16& P0, const f32x16& P1, float& sacc, u32x4 (&pw)[4]) {
    constexpr int e0 = G * 32 / 12, e1 = (G + 1) * 32 / 12, c0 = G * 16 / 12, c1 = (G + 1) * 16 / 12;
#pragma unroll
    for (int e = e0; e < e1; ++e) sacc += (e < 16 ? P0[e & 15] : P1[e & 15]);
#pragma unroll
    for (int c = c0; c < c1; ++c) { const float lo = (c < 8 ? P0[(2 * c) & 15] : P1[(2 * c) & 15]), hi = (c < 8 ? P0[(2 * c + 1) & 15] : P1[(2 * c + 1) & 15]); pw[c >> 2][c & 3] = cvtpk(lo, hi); }
}
template <int B> DI void exp4(f32x16& X) { X[B] = __builtin_amdgcn_exp2f(X[B]); X[B + 1] = __builtin_amdgcn_exp2f(X[B + 1]); X[B + 2] = __builtin_amdgcn_exp2f(X[B + 2]); X[B + 3] = __builtin_amdgcn_exp2f(X[B + 3]); }
DI float max3f(float a, float b, float c) { float r; asm("v_max3_f32 %0, %1, %2, %3" : "=v"(r) : "v"(a), "v"(b), "v"(c)); return r; }
DI float max16x2(const f32x16& a, const f32x16& b) {
    float m0 = max3f(a[0], a[1], b[0]), m1 = max3f(a[2], a[3], b[1]); m0 = max3f(m0, b[2], b[3]);
#pragma unroll
    for (int r = 4; r < 16; r += 4) { m0 = max3f(m0, a[r], a[r + 1]); m1 = max3f(m1, a[r + 2], a[r + 3]); m0 = max3f(m0, b[r], b[r + 1]); m1 = max3f(m1, b[r + 2], b[r + 3]); }
    return max3f(m0, m1, m1);
}
DI bf16x8 vfrag(const LAS unsigned char* p) { return *(const LAS bf16x8*)p; }

constexpr int NS = 6, STG = KBUF + VBUF;
DI void unit(LAS unsigned char* lds, const bf16_t* Q, const bf16_t* KN, const bf16_t* KR, const bf16_t* VT, bf16_t* O, int b, int h, int qb) {
    const int tid = opaque_tid(), lane = tid & 63, wid = __builtin_amdgcn_readfirstlane(tid >> 6), r32 = lane & 31, hi = lane >> 5;
    const size_t tok0 = (size_t)b * SEQ;
    const char* gp[3]; unsigned gstep[3]; int loff[3];
#pragma unroll
    for (int i = 0; i < 3; ++i) {
        const int j = wid * 3 + i;
        if (j < 13) {
            const int c = 64 * j + lane, row = c / 13, col = c - 13 * row;
            if (col >= 8 && col < 12) { gp[i] = (const char*)(KR + (tok0 + row) * 32 + 8 * (col - 8)); gstep[i] = 64u * 32u * 2u; }
            else { gp[i] = (const char*)(KN + (tok0 + row) * 1024 + h * 64 + 8 * (col & 7)); gstep[i] = 64u * 1024u * 2u; }
            loff[i] = j * 1024;
        } else {
            const int jj = j < 22 ? j - 13 : j - 22, c = 64 * jj + lane, row = c / 9, col = c - 9 * row;
            gp[i] = (const char*)(VT + (size_t)(h * 64 + row) * MT + tok0 + 8 * (col & 7)); gstep[i] = 128u;
            loff[i] = KBUF + jj * 1024;
        }
    }
#define DMA_TILE(T) do { const int tt_ = (T) < SEQ / 64 ? (T) : SEQ / 64 - 1; const int sl_ = (T) % NS; \
    _Pragma("unroll") for (int i_ = 0; i_ < 3; ++i_) \
        __builtin_amdgcn_global_load_lds((const unsigned*)(gp[i_] + (size_t)tt_ * gstep[i_]), (LAS unsigned*)(lds + sl_ * STG + loff[i_]), 16, 0, 0); } while (0)
#define WAIT_BAR(N) do { asm volatile("s_waitcnt vmcnt(" #N ") lgkmcnt(0)" ::: "memory"); __builtin_amdgcn_s_barrier(); asm volatile("" ::: "memory"); } while (0)
    const int kofs = r32 * KROW + 16 * hi, vofs = KBUF + r32 * VROW + 16 * hi;
    DMA_TILE(0); DMA_TILE(1); DMA_TILE(2); DMA_TILE(3);
    const bf16_t* qp = Q + (tok0 + qb * 256 + wid * 32 + r32) * 1536 + h * 96 + 8 * hi;
    bf16x8 qf[6];
#pragma unroll
    for (int d0 = 0; d0 < 6; ++d0) qf[d0] = __builtin_nontemporal_load((const bf16x8*)(qp + 16 * d0));
    f32x16 o0, o1, negm, pA0, pA1, pB0, pB1;
#pragma unroll
    for (int r = 0; r < 16; ++r) { o0[r] = 0.f; o1[r] = 0.f; negm[r] = 0.f; }
    float mhat = 0.f, lrun = 0.f;
    asm volatile("s_waitcnt vmcnt(0)" ::: "memory");
    __builtin_amdgcn_s_barrier(); asm volatile("" ::: "memory");
    DMA_TILE(4);
    bf16x8 kf[12], vf[8];
    {
        const LAS unsigned char* kb = lds + kofs;
#pragma unroll
        for (int d0 = 0; d0 < 6; ++d0) { kf[2 * d0] = *(const LAS bf16x8*)(kb + 32 * d0); kf[2 * d0 + 1] = *(const LAS bf16x8*)(kb + 32 * KROW + 32 * d0); }
#pragma unroll
        for (int d0 = 0; d0 < 6; ++d0) { pA0 = MFMA32(kf[2 * d0], qf[d0], d0 == 0 ? negm : pA0); pA1 = MFMA32(kf[2 * d0 + 1], qf[d0], d0 == 0 ? negm : pA1); }
        mhat = xhalf_max(max16x2(pA0, pA1));
#pragma unroll
        for (int r = 0; r < 16; ++r) { pA0[r] = __builtin_amdgcn_exp2f(pA0[r] - mhat); pA1[r] = __builtin_amdgcn_exp2f(pA1[r] - mhat); negm[r] = -mhat; }
        const LAS unsigned char* kb1 = lds + STG + kofs;
#pragma unroll
        for (int d0 = 0; d0 < 6; ++d0) { kf[2 * d0] = *(const LAS bf16x8*)(kb1 + 32 * d0); kf[2 * d0 + 1] = *(const LAS bf16x8*)(kb1 + 32 * KROW + 32 * d0); }
    }
    WAIT_BAR(3);
#define PIN(x) asm volatile("" : "+v"(x))
#define VRD(i) vf[i] = *(const LAS bf16x8*)(vb + ((i) & 1) * 32 * VROW + ((i) >> 1) * 32)
#define KRD(i) kf[i] = *(const LAS bf16x8*)(kbn + ((i) & 1) * 32 * KROW + ((i) >> 1) * 32)
#define QKSTEP(C0, C1, P0, P1, d0, G0, G1) \
    if (G0 < 8) VRD(G0); \
    C0 = MFMA32(kf[2 * d0], qf[d0], d0 == 0 ? negm : C0); valu_a<G0>(P0, P1, sacc, pw); PIN(sacc); PIN(pw[(G0 * 16 / 12) >> 2]); SBAR(); \
    if (G1 < 8) VRD(G1); \
    C1 = MFMA32(kf[2 * d0 + 1], qf[d0], d0 == 0 ? negm : C1); valu_a<G1>(P0, P1, sacc, pw); PIN(sacc); PIN(pw[(G1 * 16 / 12) >> 2]); SBAR();
#define PVSTEP(ks, X, B) \
    if (ks < 2) { KRD(4 * ks); KRD(4 * ks + 1); } else { KRD(2 * ks + 4); } \
    o0 = MFMA32(vf[2 * ks], __builtin_bit_cast(bf16x8, pw[ks]), o0); exp4<B>(X); PIN(X); SBAR(); \
    if (ks < 2) { KRD(4 * ks + 2); KRD(4 * ks + 3); } else { KRD(2 * ks + 5); } \
    o1 = MFMA32(vf[2 * ks + 1], __builtin_bit_cast(bf16x8, pw[ks]), o1); exp4<B + 4>(X); PIN(X); SBAR();
#define STEP(C0, C1, P0, P1, T, DOMAX) do { \
    const int t_ = (T); \
    DMA_TILE(t_ + 4); \
    const LAS unsigned char* vb = lds + ((t_ - 1) % NS) * STG + vofs; \
    const LAS unsigned char* kbn = lds + ((t_ + 1) % NS) * STG + kofs; \
    asm volatile("" : "+v"(vb), "+v"(kbn));     \
    float sacc = 0.f; u32x4 pw[4]; \
    SBAR(); __builtin_amdgcn_s_setprio(1); \
    QKSTEP(C0, C1, P0, P1, 0, 0, 1) QKSTEP(C0, C1, P0, P1, 1, 2, 3) QKSTEP(C0, C1, P0, P1, 2, 4, 5) \
    QKSTEP(C0, C1, P0, P1, 3, 6, 7) QKSTEP(C0, C1, P0, P1, 4, 8, 9) QKSTEP(C0, C1, P0, P1, 5, 10, 11) \
    __builtin_amdgcn_s_setprio(0); lrun += sacc; \
    float rm = 0.f; if (DOMAX) rm = xhalf_max(max16x2(C0, C1));     \
    SBAR(); \
    PVSTEP(0, C0, 0) PVSTEP(1, C0, 8) PVSTEP(2, C1, 0) PVSTEP(3, C1, 8) \
    WAIT_BAR(6); \
    if (DOMAX) if (__builtin_expect(__any(rm > THR), 0)) { const float dl = fmaxf(rm, 0.f), fres = __builtin_amdgcn_exp2f(-dl); mhat += dl; lrun *= fres; \
        _Pragma("unroll") for (int r = 0; r < 16; ++r) { C0[r] *= fres; C1[r] *= fres; o0[r] *= fres; o1[r] *= fres; negm[r] = -mhat; } \
        PIN(C0); PIN(C1); PIN(o0); PIN(o1); PIN(negm); } \
    } while (0)
    int t = 1;
    for (; t + 1 < SEQ / 64; t += 2) {
        STEP(pB0, pB1, pA0, pA1, t, true);
        STEP(pA0, pA1, pB0, pB1, t + 1, false);
    }
    STEP(pB0, pB1, pA0, pA1, SEQ / 64 - 1, true);
    {
        float sacc = 0.f; u32x4 pw[4];
        valu_a<0>(pB0, pB1, sacc, pw); valu_a<1>(pB0, pB1, sacc, pw); valu_a<2>(pB0, pB1, sacc, pw); valu_a<3>(pB0, pB1, sacc, pw);
        valu_a<4>(pB0, pB1, sacc, pw); valu_a<5>(pB0, pB1, sacc, pw); valu_a<6>(pB0, pB1, sacc, pw); valu_a<7>(pB0, pB1, sacc, pw);
        valu_a<8>(pB0, pB1, sacc, pw); valu_a<9>(pB0, pB1, sacc, pw); valu_a<10>(pB0, pB1, sacc, pw); valu_a<11>(pB0, pB1, sacc, pw);
        lrun += sacc;
        const LAS unsigned char* vb = lds + ((SEQ / 64 - 1) % NS) * STG + vofs;
#pragma unroll
        for (int ks = 0; ks < 4; ++ks) {
            o0 = MFMA32(vfrag(vb + 32 * ks), __builtin_bit_cast(bf16x8, pw[ks]), o0);
            o1 = MFMA32(vfrag(vb + 32 * VROW + 32 * ks), __builtin_bit_cast(bf16x8, pw[ks]), o1);
        }
    }
#undef STEP
#undef QKSTEP
#undef PVSTEP
#undef PIN
#undef VRD
#undef KRD
    const float inv = 1.0f / xhalf_sum(lrun);
    bf16_t* orow = O + (tok0 + qb * 256 + wid * 32 + r32) * 1024 + h * 64 + 8 * hi;
#pragma unroll
    for (int dt = 0; dt < 2; ++dt)
#pragma unroll
        for (int g = 0; g < 4; g += 2) {
            const f32x16& oo = dt == 0 ? o0 : o1;
            u32x2 a, b;
            a.x = cvtpk(oo[4 * g] * inv, oo[4 * g + 1] * inv); a.y = cvtpk(oo[4 * g + 2] * inv, oo[4 * g + 3] * inv);
            b.x = cvtpk(oo[4 * g + 4] * inv, oo[4 * g + 5] * inv); b.y = cvtpk(oo[4 * g + 6] * inv, oo[4 * g + 7] * inv);
            { auto r = __builtin_amdgcn_permlane32_swap(a.x, b.x, false, false); a.x = r[0]; b.x = r[1]; }
            { auto r = __builtin_amdgcn_permlane32_swap(a.y, b.y, false, false); a.y = r[0]; b.y = r[1]; }
            u32x4 w; w.x = a.x; w.y = a.y; w.z = b.x; w.w = b.y;
            *(u32x4*)(orow + 32 * dt + 8 * g) = w;
        }
    WAIT_BAR(0);
#undef DMA_TILE
#undef WAIT_BAR
}
#undef SBAR
#undef MFMA32
}

typedef __attribute__((address_space(1))) unsigned gu32;
#define RLX_AGENT __ATOMIC_RELAXED, __HIP_MEMORY_SCOPE_AGENT
#define XB_TMO      128
#define XB_XCNT(j)  (256  + 64 * (j))
#define XB_XSUB(j)  (1280 + 64 * (j))
#define XB_XGEN(j)  (2304 + 64 * (j))
#define XB_TOP      3328
#define XB_TOPGEN   3392
#define XCD_BAR_WORDS 3456
#define XB_SPIN_CAP (1u << 18)

__device__ __forceinline__ unsigned xb_ld(unsigned* p)              { return __hip_atomic_load(p, __ATOMIC_RELAXED, __HIP_MEMORY_SCOPE_AGENT); }
__device__ __forceinline__ unsigned xb_add(unsigned* p, unsigned v) { return __hip_atomic_fetch_add(p, v, __ATOMIC_RELAXED, __HIP_MEMORY_SCOPE_AGENT); }
__device__ __forceinline__ unsigned xb_xcc_id() { return (unsigned)__builtin_amdgcn_s_getreg((3 << 11) | 20) & 0xFu; }
#define XB_SPIN(cond, bar) do { unsigned _sp = 0; while (cond) { __builtin_amdgcn_s_sleep(1); \
    if ((++_sp & 255u) == 0u) { if (xb_ld(&(bar)[XB_TMO])) break; if (_sp > XB_SPIN_CAP) { atomicAdd(&(bar)[XB_TMO], 1u); break; } } } } while (0)

struct XcdBarrier {
    unsigned* bar; unsigned x;
    volatile LAS unsigned* st;
};

__device__ __forceinline__ XcdBarrier xcd_barrier_post(unsigned* bar, volatile LAS unsigned* st) {
    XcdBarrier b; b.bar = bar; b.x = xb_xcc_id(); b.st = st;
    if (threadIdx.x == 0) (void)xb_add(&bar[XB_XCNT(b.x)], 1u);
    return b;
}
__device__ __forceinline__ void xcd_barrier_complete(unsigned* bar, unsigned x, unsigned& nloc, unsigned& nx) {
    const unsigned G = gridDim.x * gridDim.y * gridDim.z;
    unsigned sum, cnt, mine, sp = 0u;
    for (;;) {
        sum = 0u; cnt = 0u; mine = 0u;
#pragma unroll
        for (unsigned j = 0; j < 16; ++j) { const unsigned c = xb_ld(&bar[XB_XCNT(j)]); sum += c; cnt += (c > 0u) ? 1u : 0u; mine = (j == x) ? c : mine; }
        if (sum == G) break;
        __builtin_amdgcn_s_sleep(1);
        if ((++sp & 255u) == 0u) { if (xb_ld(&bar[XB_TMO])) break; if (sp > XB_SPIN_CAP) { atomicAdd(&bar[XB_TMO], 1u); break; } }
    }
    nloc = mine > 0u ? mine : 1u; nx = cnt > 0u ? cnt : 1u;
}

__device__ __forceinline__ void xcd_barrier(const XcdBarrier& b) {
    asm volatile("s_waitcnt vmcnt(0)" ::: "memory");
    __syncthreads();
    if (threadIdx.x == 0) {
        unsigned* bar = b.bar;
        __builtin_amdgcn_s_waitcnt(0);
        unsigned nloc = b.st[0], nx = b.st[1];
        if (nloc == 0u) { xcd_barrier_complete(bar, b.x, nloc, nx); b.st[0] = nloc; b.st[1] = nx; }
        const unsigned old = xb_add(&bar[XB_XSUB(b.x)], 1u);
        const unsigned gen = old / nloc;
        if (old + 1u == (gen + 1u) * nloc) {
            __builtin_amdgcn_fence(__ATOMIC_RELEASE, "agent");
            asm volatile("s_waitcnt vmcnt(0)" ::: "memory");
            const unsigned og = xb_add(&bar[XB_TOP], 1u);
            const unsigned tg = og / nx;
            if (og + 1u == (tg + 1u) * nx) xb_add(&bar[XB_TOPGEN], 1u);
            else XB_SPIN(xb_ld(&bar[XB_TOPGEN]) == tg, bar);
            __builtin_amdgcn_fence(__ATOMIC_ACQUIRE, "agent");
            xb_add(&bar[XB_XGEN(b.x)], 1u);
            asm volatile("s_waitcnt vmcnt(0)" ::: "memory");
        } else {
            XB_SPIN(xb_ld(&bar[XB_XGEN(b.x)]) == gen, bar);
            __builtin_amdgcn_fence(__ATOMIC_ACQUIRE, "agent");
            asm volatile("s_waitcnt vmcnt(0)" ::: "memory");
        }
    }
    __syncthreads();
}

struct Args { const float* in[17]; float* out; unsigned char* ws; };
__global__ void __launch_bounds__(512, 2) fwd_megakernel(Args a) {
    extern __shared__ __attribute__((aligned(16))) unsigned char lds_raw[];
    LAS unsigned char* lds = (LAS unsigned char*)lds_raw;
    cg::grid_group grid = cg::this_grid();
    const int G = gridDim.x, bx = blockIdx.x;
    const int vcu = (G % 8 == 0) ? (bx % 8) * (G / 8) + bx / 8 : bx;
    unsigned char* ws = a.ws;
    const float* x_in = a.in[0]; const float* c_in = a.in[1]; const float* ada_w = a.in[2]; const float* ada_b = a.in[3]; const float* norm_g = a.in[4];
    const float* ffn_w_in = a.in[5]; const float* ffn_w_out = a.in[6]; const float* pool_w = a.in[7]; const float* pool_b = a.in[8]; const float* pool_scale = a.in[9];
    const float* mla_w_in = a.in[10]; const float* mla_q_norm = a.in[11]; const float* mla_kv_norm = a.in[12]; const float* mla_w_uq = a.in[13];
    const float* mla_w_uk = a.in[14]; const float* mla_w_uv = a.in[15]; const float* mla_w_o = a.in[16];
    float* X = a.out;
    bf16_t* XB = (bf16_t*)a.out;
    bf16_t* XB2 = (bf16_t*)(ws + WS_KN);
    float* mod = (float*)(ws + WS_MOD);
    float* cosT = (float*)(ws + WS_ROPE); float* sinT = cosT + SEQ * 16;
    bf16_t* Hb = (bf16_t*)(ws + WS_H); bf16_t* Yb = (bf16_t*)(ws + WS_Y); bf16_t* ACT = (bf16_t*)(ws + WS_ACT);
    bf16_t* Wp_t = (bf16_t*)(ws + WS_WP); bf16_t* Wlat_t = (bf16_t*)(ws + WS_WLAT); bf16_t* Wq_t = (bf16_t*)(ws + WS_WQ);
    bf16_t* Wuk_t = (bf16_t*)(ws + WS_WUK); bf16_t* Wuv_t = (bf16_t*)(ws + WS_WUV); bf16_t* Wo_t = (bf16_t*)(ws + WS_WO);
    float* LAT = (float*)(ws + WS_LAT); bf16_t* CQ = (bf16_t*)(ws + WS_CQ); bf16_t* CKV = (bf16_t*)(ws + WS_CKV); bf16_t* CKV2 = (bf16_t*)(ws + WS_CKV2); bf16_t* KR = (bf16_t*)(ws + WS_KR);
    bf16_t* Qb = (bf16_t*)(ws + WS_Q); bf16_t* KN = (bf16_t*)(ws + WS_KN); bf16_t* VT = (bf16_t*)(ws + WS_VT); bf16_t* Ob = (bf16_t*)(ws + WS_O); bf16_t* PD = (bf16_t*)(ws + WS_PD);
    if (threadIdx.x < 64) ((LAS unsigned*)(lds + RING_BYTES))[threadIdx.x] = 0u;
    __syncthreads();
    const XcdBarrier xbar = xcd_barrier_post((unsigned*)(ws + WS_CTL) + CW_BAR, (volatile LAS unsigned*)(lds + RING_BYTES) + 8);
#define GRID_SYNC() xcd_barrier(xbar)
#define MODP(l, i) (mod + (size_t)(l) * 8 * 9216 + (i) * 1024)
#define NG(l, i) (norm_g + ((l) * 6 + (i)) * 1024)

    {
        const int tid = opaque_tid(), lane = tid & 63, wave = __builtin_amdgcn_readfirstlane(tid >> 6), gw = vcu * 8 + wave, ngw = G * 8;
        LAS float* sc = (LAS float*)(lds + 69632);
        for (int idx = tid; idx < 8192; idx += 512) { const float v = c_in[idx]; sc[(idx & 1023) * 8 + (idx >> 10)] = v / (1.0f + __expf(-v)); }
        __syncthreads();
        LAS float* scr = (LAS float*)(lds + wave * 8448);
        constexpr int I_W1 = 16 * 176, I_W2 = 44 * 32, I_WP = 4 * 8, I_WLAT = 16 * 13, I_WQ = 4 * 48, I_WUK = 2 * 32, I_WO = 16 * 32, I_ADA = 576;
        constexpr int NITEMS = I_ADA + 4 * I_W1 + 4 * I_W2 + 4 * I_WP + I_WLAT + I_WQ + 2 * I_WUK + I_WO;
        constexpr int NTR = NITEMS - I_ADA;
        const bool split = ngw > I_ADA;
        if (gw < I_ADA) ada_item(ada_w, ada_b, mod, sc, gw, lane);
        if (!split) for (int it = gw + ngw; it < I_ADA; it += ngw) ada_item(ada_w, ada_b, mod, sc, it, lane);
        const int tr_first = split ? (gw < I_ADA ? gw : I_ADA + (gw - I_ADA)) : gw, tr_step = split ? (gw < I_ADA ? NTR : ngw - I_ADA) : ngw;
        for (int it = tr_first; it < NTR; it += tr_step) {
            int r = it;
            if (r < 4 * I_W1) { const int q = r / I_W1; transpose_item(ffn_w_in + (size_t)q * 1024 * 5632, 1024, 5632, (bf16_t*)(ws + WS_W1 + q * W1_BYTES), 1, 0, scr, r - q * I_W1, lane); continue; } r -= 4 * I_W1;
            if (r < 4 * I_W2) { const int q = r / I_W2; transpose_item(ffn_w_out + (size_t)q * 2816 * 1024, 2816, 1024, (bf16_t*)(ws + WS_W2 + q * W2_BYTES), 0, 0, scr, r - q * I_W2, lane); continue; } r -= 4 * I_W2;
            if (r < 4 * I_WP) { const int q = r / I_WP; transpose_item(pool_w + (size_t)q * 65536, 256, 256, Wp_t, 0, q * 256, scr, r - q * I_WP, lane); continue; } r -= 4 * I_WP;
            if (r < I_WLAT) { transpose_item(mla_w_in, 1024, 416, Wlat_t, 3, 0, scr, r, lane); continue; } r -= I_WLAT;
            if (r < I_WQ) { transpose_item(mla_w_uq, 256, 1536, Wq_t, 2, 0, scr, r, lane); continue; } r -= I_WQ;
            if (r < I_WUK) { transpose_item(mla_w_uk, 128, 1024, Wuk_t, 0, 0, scr, r, lane); continue; } r -= I_WUK;
            if (r < I_WUK) { transpose_item(mla_w_uv, 128, 1024, Wuv_t, 0, 0, scr, r, lane); continue; } r -= I_WUK;
            transpose_item(mla_w_o, 1024, 1024, Wo_t, 0, 0, scr, r, lane);
        }
        for (int idx = bx * 512 + tid; idx < SEQ * 16; idx += G * 512) rope_entry(cosT, sinT, idx);
        for (int idx = bx * 512 + tid; idx < 96 * 1024 / 8; idx += G * 512) ((u32x4*)(Wlat_t + 416 * 1024))[idx] = (u32x4){0u, 0u, 0u, 0u};
    }
    GRID_SYNC();
    if (gridDim.x > 1048576u) grid.sync();
    rows_phase<false, true, false, false>(x_in, nullptr, nullptr, nullptr, nullptr, 0.f, NG(0, 0), MODP(0, 0), MODP(0, 1), Hb, vcu, G);
    GRID_SYNC();

#define FFN_PHASE(l, f) do { \
        { pg8::Gemm g{Hb, (const bf16_t*)(ws + WS_W1 + (size_t)((l) * 2 + (f)) * W1_BYTES), MT, 2 * FF, DM, 0}; pg8::StaticOrder S; S.init(MT, 2 * FF, G, bx); \
          pg8::EpiSwiglu E{ACT, FF}; pg8::gemm_phase(lds, g, S, E); } \
        GRID_SYNC(); \
        { pg8::Gemm g{ACT, (const bf16_t*)(ws + WS_W2 + (size_t)((l) * 2 + (f)) * W2_BYTES), MT, DM, FF, 0}; pg8::StaticOrder S; S.init(MT, DM, G, bx); \
          pg8::EpiStore E{Yb, DM, nullptr, nullptr}; pg8::gemm_phase<pg8::EpiStore, false>(lds, g, S, E); } \
        GRID_SYNC(); } while (0)

    FFN_PHASE(0, 0);
    rows_phase<true, true, false, true>(x_in, XB, Yb, NG(0, 1), MODP(0, 2), 0.5f, NG(0, 2), MODP(0, 3), MODP(0, 4), Hb, vcu, G);
    if (MT % (G * 32) == 0) {
        const int tid = opaque_tid(), lane = tid & 63, wave = __builtin_amdgcn_readfirstlane(tid >> 6);
        const int rpb = MT / G, r0 = vcu * rpb, tb = r0 & (SEQ - 1);
        const int hrow = wave < 4 ? r0 - 8 + 2 * wave : r0 + rpb + 2 * (wave - 4);
        const bool hvalid = wave < 4 ? (tb >= 8) : (tb + rpb + 8 <= SEQ);
        if (hvalid) rows_range<true, true, false, false, false>(x_in, nullptr, Yb, NG(0, 1), MODP(0, 2), 0.5f, NG(0, 2), MODP(0, 3), MODP(0, 4), Hb, hrow, 2, lane);
        asm volatile("s_waitcnt vmcnt(0)" ::: "memory");
        __syncthreads();
        if (tid == 0) { __builtin_amdgcn_fence(__ATOMIC_ACQUIRE, "agent"); asm volatile("s_waitcnt vmcnt(0)" ::: "memory"); }
        __syncthreads();
        for (int ci = r0 / 32; ci < (r0 + rpb) / 32; ++ci) {
            const int b = ci >> 7, t0 = (ci & 127) * 32, gsel = wave >> 1;
            if (gsel == 0) pool_chunk<2>(Hb, PD, b, t0, tid);
            else if (gsel == 1) pool_chunk<4>(Hb, PD, b, t0, tid);
            else if (gsel == 2) pool_chunk<8>(Hb, PD, b, t0, tid);
            else pool_chunk<16>(Hb, PD, b, t0, tid);
        }
    } else {
        GRID_SYNC();
        for (int ci = vcu; ci < MT / 32; ci += G) {
            const int tid = opaque_tid(), wave = __builtin_amdgcn_readfirstlane(tid >> 6);
            const int b = ci >> 7, t0 = (ci & 127) * 32, gsel = wave >> 1;
            if (gsel == 0) pool_chunk<2>(Hb, PD, b, t0, tid);
            else if (gsel == 1) pool_chunk<4>(Hb, PD, b, t0, tid);
            else if (gsel == 2) pool_chunk<8>(Hb, PD, b, t0, tid);
            else pool_chunk<16>(Hb, PD, b, t0, tid);
        }
    }
    GRID_SYNC();
    {
        pg8::Gemm g{PD, Wp_t, MT, DM, 256, (size_t)MT * 256 * 2}; pg8::StaticOrder S; S.init(MT, DM, G, bx);
        pg8::EpiStore E{Yb, DM, pool_b, pool_scale};
        pg8::gemm_phase<pg8::EpiStore, false>(lds, g, S, E);
    }
    GRID_SYNC();
    rows_phase<true, true, true, true>(XB, XB, Yb, NG(0, 3), MODP(0, 5), 1.0f, NG(0, 4), MODP(0, 6), MODP(0, 7), Hb, vcu, G);
    GRID_SYNC();
    FFN_PHASE(0, 1);
    rows_phase<true, true, true, true>(XB, XB, Yb, NG(0, 5), MODP(0, 8), 0.5f, NG(1, 0), MODP(1, 0), MODP(1, 1), Hb, vcu, G);
    GRID_SYNC();

    FFN_PHASE(1, 0);
    rows_phase<true, true, true, true>(XB, XB, Yb, NG(1, 1), MODP(1, 2), 0.5f, NG(1, 2), MODP(1, 3), MODP(1, 4), Hb, vcu, G);
    GRID_SYNC();
    if (G * 1 == (MT / 256) * 2) {
        pg8::Gemm g{Hb, Wlat_t, MT, 512, DM, 0}; pg8::StaticOrder S; S.init(MT, 512, G, bx);
        pg8::EpiLat E{mla_q_norm, mla_kv_norm, cosT, sinT, CQ, CKV, CKV2, KR};
        pg8::gemm_phase(lds, g, S, E);
    } else {
        {
            pg8::Gemm g{Hb, Wlat_t, MT, 512, DM, 0}; pg8::StaticOrder S; S.init(MT, 512, G, bx);
            pg8::EpiF32 E{LAT, 512};
            pg8::gemm_phase(lds, g, S, E);
        }
        GRID_SYNC();
        lat_rows_phase(LAT, mla_q_norm, mla_kv_norm, cosT, sinT, CQ, CKV, CKV2, KR, vcu, G);
    }
    GRID_SYNC();
    {
        pg8::Gemm g{CQ, Wq_t, MT, 1536, 256, 0}; pg8::StaticOrder S; S.init(MT, 1536, G, bx);
        pg8::EpiQ E{Qb, cosT, sinT};
        pg8::gemm_phase<pg8::EpiQ, false>(lds, g, S, E);
    }
    {
        pg8::Gemm g{CKV, Wuk_t, MT, 1024, 128, 0}; pg8::StaticOrder S; S.init(MT, 1024, G, bx);
        pg8::EpiStore E{KN, 1024, nullptr, nullptr};
        pg8::gemm_phase<pg8::EpiStore, false>(lds, g, S, E);
    }
    {
        pg8::Gemm g{Wuv_t, CKV2, 1024, MT, 128, 0}; pg8::StaticOrder S; S.init(1024, MT, G, bx);
        pg8::EpiStore E{VT, MT, nullptr, nullptr};
        pg8::gemm_phase<pg8::EpiStore, false>(lds, g, S, E);
    }
    GRID_SYNC();
    for (int U = vcu; U < NB * NH * 16; U += G) {
        const int bh = U >> 4, qb = U & 15;
        att::unit(lds, Qb, KN, KR, VT, Ob, bh >> 4, bh & 15, qb);
    }
    GRID_SYNC();
    {
        pg8::Gemm g{Ob, Wo_t, MT, DM, DM, 0}; pg8::StaticOrder S; S.init(MT, DM, G, bx);
        pg8::EpiStore E{Yb, DM, nullptr, nullptr};
        pg8::gemm_phase<pg8::EpiStore, false>(lds, g, S, E);
    }
    GRID_SYNC();
    rows_phase<true, true, true, true>(XB, XB2, Yb, NG(1, 3), MODP(1, 5), 1.0f, NG(1, 4), MODP(1, 6), MODP(1, 7), Hb, vcu, G);
    GRID_SYNC();
    FFN_PHASE(1, 1);
    rows_phase<true, false, true, false>(XB2, X, Yb, NG(1, 5), MODP(1, 8), 0.5f, nullptr, nullptr, nullptr, nullptr, vcu, G);
}

extern "C" void kernel_launch(void* const* d_in, const int* in_sizes, int n_in, void* d_out, int out_size, void* d_ws, size_t ws_size, hipStream_t stream) {
    static int grid = 0;
    if (grid == 0) {
        if (n_in != 17 || out_size != MT * DM || ws_size < WS_END) { fprintf(stderr, "kernel_launch: unexpected shapes (n_in %d out %d ws %zu)\n", n_in, out_size, ws_size); grid = -1; return; }
        int dev = 0, cus = 0, per_cu = 0;
        hipGetDevice(&dev);
        hipDeviceGetAttribute(&cus, hipDeviceAttributeMultiprocessorCount, dev);
        hipFuncSetAttribute((const void*)fwd_megakernel, hipFuncAttributeMaxDynamicSharedMemorySize, LDS_BYTES);
        hipOccupancyMaxActiveBlocksPerMultiprocessor(&per_cu, (const void*)fwd_megakernel, 512, LDS_BYTES);
        (void)hipGetLastError();
        if (per_cu < 1) { fprintf(stderr, "kernel_launch: occupancy query says %d blocks per CU\n", per_cu); per_cu = 1; }
        grid = cus;
    }
    if (grid < 0) return;
    if (hipMemsetAsync((char*)d_ws + WS_CTL, 0, 65536, stream) != hipSuccess) { fprintf(stderr, "kernel_launch: memset of control words failed\n"); return; }
    Args a{};
    for (int i = 0; i < 17; ++i) a.in[i] = (const float*)d_in[i];
    a.out = (float*)d_out; a.ws = (unsigned char*)d_ws;
    void* args[] = {&a};
    hipError_t e = hipLaunchCooperativeKernel((const void*)fwd_megakernel, dim3(grid), dim3(512), args, LDS_BYTES, stream);
    if (e != hipSuccess) fprintf(stderr, "cooperative launch failed: %s (grid %d)\n", hipGetErrorString(e), grid);
}
```

```cpp
#include <hip/hip_runtime.h>
#include <hip/hip_cooperative_groups.h>
#include <cstdio>
#include <cstdint>
namespace cg = cooperative_groups;

#define LAS __attribute__((address_space(3)))
typedef unsigned short bf16_t;
typedef short bf16x8 __attribute__((ext_vector_type(8)));
typedef short s16x4 __attribute__((ext_vector_type(4)));
typedef float f32x4 __attribute__((ext_vector_type(4)));
typedef float f32x16 __attribute__((ext_vector_type(16)));
typedef unsigned u32x4 __attribute__((ext_vector_type(4)));
typedef unsigned u32x2 __attribute__((ext_vector_type(2)));
typedef float f32x2_t __attribute__((ext_vector_type(2)));
typedef __bf16 bf16x2_t __attribute__((ext_vector_type(2)));
#define DI __device__ __forceinline__

DI unsigned cvtpk(float lo, float hi) { f32x2_t v = {lo, hi}; bf16x2_t b = __builtin_convertvector(v, bf16x2_t); return __builtin_bit_cast(unsigned, b); }
DI float bflo(unsigned u) { return __uint_as_float(u << 16); }
DI float bfhi(unsigned u) { return __uint_as_float(u & 0xffff0000u); }
DI int opaque_tid() { int t = threadIdx.x; asm volatile("" : "+v"(t)); return t; }
DI float wave_sum(float v) {
#pragma unroll
    for (int o = 1; o < 64; o <<= 1) v += __shfl_xor(v, o);
    return v;
}

constexpr int NB = 8, SEQ = 4096, DM = 1024, NH = 16, FF = 2816, MT = NB * SEQ;
constexpr float EPS = 1e-6f;
constexpr float QSCALE = 0.10206207261596577f * 1.4426950408889634f;
constexpr size_t MiB = 1u << 20;
constexpr size_t WS_CTL = 0, WS_MOD = 1 * MiB, WS_ROPE = 2 * MiB;
constexpr size_t W1_BYTES = (size_t)5632 * 1024 * 2, W2_BYTES = (size_t)1024 * 2816 * 2;
constexpr size_t WS_W1 = 8 * MiB;
constexpr size_t WS_W2 = WS_W1 + 4 * W1_BYTES;
constexpr size_t WS_WP = WS_W2 + 4 * W2_BYTES;
constexpr size_t WS_WLAT = WS_WP + 1024 * 256 * 2;
constexpr size_t WS_WQ = WS_WLAT + 512 * 1024 * 2;
constexpr size_t WS_WUK = WS_WQ + 1536 * 256 * 2;
constexpr size_t WS_WUV = WS_WUK + 1024 * 128 * 2;
constexpr size_t WS_WO = WS_WUV + 1024 * 128 * 2;
constexpr size_t WS_WEND = WS_WO + 1024 * 1024 * 2;
static_assert(WS_WEND <= 88 * MiB, "weights");
constexpr size_t WS_H = 88 * MiB, WS_Y = 152 * MiB, WS_ACT = 216 * MiB;
constexpr size_t WS_LAT = 216 * MiB, WS_CQ = 280 * MiB, WS_CKV = 296 * MiB, WS_KR = 304 * MiB, WS_Q = 306 * MiB, WS_KN = 402 * MiB;
constexpr size_t WS_CKV2 = 466 * MiB;
constexpr size_t WS_VT = WS_H, WS_O = WS_LAT, WS_PD = WS_ACT, WS_END = 474 * MiB;
constexpr int RING_BYTES = 135168, LDS_BYTES = RING_BYTES + 256;
constexpr int CW_BAR = 1024;

namespace pg8 {
constexpr int BM = 256, BK = 64, HALF = 128, HTB = HALF * BK * 2, NXCD = 8, WGM = 8;
DI int lds_byte(int r, int c) { const int st = (r >> 4) * 2 + (c >> 5), rr = r & 15, cc = c & 31, ob = rr * 64 + cc * 2; return st * 1024 + (ob ^ (((ob >> 9) & 1) << 5)); }
DI void stage_rc(int b, int& R, int& C) { const int st = b / 1024, sb = b % 1024, swz = sb ^ (((sb >> 9) & 1) << 5); R = (st >> 1) * 16 + swz / 64; C = (st & 1) * 32 + (swz % 64) / 2; }
DI int perm32(int rho) { const int n = rho >> 4, i = rho & 15; return 8 * (i >> 2) + 4 * n + (i & 3); }
struct Unit { int pm, pn; };
struct Gemm { const bf16_t* A; const bf16_t* Bt; int M, N, K; size_t a_pn_stride; };
struct StaticOrder {
    int nM, nN, nwg, G, c;
    DI void init(int M, int N, int G_, int c_) { nM = M / BM; nN = N / BM; nwg = nM * nN; G = G_; c = c_; }
    DI bool next(int i, Unit& u) const {
        const long L = (long)i * G + c; if (L >= nwg) return false;
        int wgid = (int)L; { const int q = nwg / NXCD, r = nwg % NXCD, xcd = wgid % NXCD, off = wgid / NXCD; wgid = (xcd < r ? xcd * (q + 1) : r * (q + 1) + (xcd - r) * q) + off; }
        const int nig = WGM * nN, gid = wgid / nig, fm = gid * WGM, gsz = (nM - fm) < WGM ? (nM - fm) : WGM;
        u.pm = fm + ((wgid % nig) % gsz); u.pn = (wgid % nig) / gsz; return true;
    }
};

struct EpiStore {
    static constexpr bool AFTER_DRAIN = false;
    bf16_t* O; int ldc; const float* bias; const float* cs;
    DI void operator()(const f32x4 (&acc)[2][2][4][2], const Unit& u, int wr, int wc, int fr, int fq) const {
        const int row0 = u.pm * BM + wr * 64 + fr, col0 = u.pn * BM + wc * 32 + 8 * fq;
        f32x4 bv[2][2], sv[2][2];
#pragma unroll
        for (int bj = 0; bj < 2; ++bj)
#pragma unroll
            for (int n = 0; n < 2; ++n) {
                bv[bj][n] = bias ? *(const f32x4*)(bias + col0 + bj * HALF + 4 * n) : (f32x4){0.f, 0.f, 0.f, 0.f};
                sv[bj][n] = cs ? *(const f32x4*)(cs + col0 + bj * HALF + 4 * n) : (f32x4){1.f, 1.f, 1.f, 1.f};
            }
#pragma unroll
        for (int ai = 0; ai < 2; ++ai)
#pragma unroll
            for (int m = 0; m < 4; ++m) {
                bf16_t* rowp = O + (size_t)(row0 + ai * HALF + m * 16) * ldc + col0;
#pragma unroll
                for (int bj = 0; bj < 2; ++bj) {
                    const f32x4 v0 = (acc[ai][bj][m][0] + bv[bj][0]) * sv[bj][0], v1 = (acc[ai][bj][m][1] + bv[bj][1]) * sv[bj][1];
                    u32x4 w; w.x = cvtpk(v0[0], v0[1]); w.y = cvtpk(v0[2], v0[3]); w.z = cvtpk(v1[0], v1[1]); w.w = cvtpk(v1[2], v1[3]);
                    *(u32x4*)(rowp + bj * HALF) = w;
                }
            }
    }
};
struct EpiF32 {
    static constexpr bool AFTER_DRAIN = false;
    float* O; int ldc;
    DI void operator()(const f32x4 (&acc)[2][2][4][2], const Unit& u, int wr, int wc, int fr, int fq) const {
        const int row0 = u.pm * BM + wr * 64 + fr, col0 = u.pn * BM + wc * 32 + 8 * fq;
#pragma unroll
        for (int ai = 0; ai < 2; ++ai)
#pragma unroll
            for (int m = 0; m < 4; ++m) {
                float* rowp = O + (size_t)(row0 + ai * HALF + m * 16) * ldc + col0;
#pragma unroll
                for (int bj = 0; bj < 2; ++bj) { *(f32x4*)(rowp + bj * HALF) = acc[ai][bj][m][0]; *(f32x4*)(rowp + bj * HALF + 4) = acc[ai][bj][m][1]; }
            }
    }
};
struct EpiSwiglu {
    static constexpr bool AFTER_DRAIN = false;
    bf16_t* O; int ldc;
    DI void operator()(const f32x4 (&acc)[2][2][4][2], const Unit& u, int wr, int wc, int fr, int fq) const {
        const int row0 = u.pm * BM + wr * 64 + fr, col0 = u.pn * HALF + wc * 32 + 8 * fq;
#pragma unroll
        for (int ai = 0; ai < 2; ++ai)
#pragma unroll
            for (int m = 0; m < 4; ++m) {
                float a[8];
#pragma unroll
                for (int n = 0; n < 2; ++n)
#pragma unroll
                    for (int e = 0; e < 4; ++e) {
                        const float g = acc[ai][0][m][n][e], up = acc[ai][1][m][n][e];
                        const float sg = __builtin_amdgcn_rcpf(1.0f + __builtin_amdgcn_exp2f(-1.4426950408889634f * g));
                        a[4 * n + e] = g * sg * up;
                    }
                u32x4 w; w.x = cvtpk(a[0], a[1]); w.y = cvtpk(a[2], a[3]); w.z = cvtpk(a[4], a[5]); w.w = cvtpk(a[6], a[7]);
                *(u32x4*)(O + (size_t)(row0 + ai * HALF + m * 16) * ldc + col0) = w;
            }
    }
};
struct EpiQ {
    static constexpr bool AFTER_DRAIN = false;
    bf16_t* O; const float* cosT; const float* sinT;
    DI void operator()(const f32x4 (&acc)[2][2][4][2], const Unit& u, int wr, int wc, int fr, int fq) const {
        const int row0 = u.pm * BM + wr * 64 + fr, col0 = u.pn * BM + wc * 32 + 8 * fq;
#pragma unroll
        for (int ai = 0; ai < 2; ++ai)
#pragma unroll
            for (int m = 0; m < 4; ++m) {
                const int row = row0 + ai * HALF + m * 16, s = row & (SEQ - 1);
#pragma unroll
                for (int bj = 0; bj < 2; ++bj) {
                    const int col = col0 + bj * HALF, hc = col % 96;
                    f32x4 v0 = acc[ai][bj][m][0], v1 = acc[ai][bj][m][1];
                    if (hc >= 64) {
                        const int j0 = (hc - 64) >> 1;
                        const f32x4 cs = *(const f32x4*)(cosT + s * 16 + j0), sn = *(const f32x4*)(sinT + s * 16 + j0);
                        const f32x4 t0 = v0, t1 = v1;
                        v0[0] = t0[0] * cs[0] - t0[1] * sn[0]; v0[1] = t0[1] * cs[0] + t0[0] * sn[0];
                        v0[2] = t0[2] * cs[1] - t0[3] * sn[1]; v0[3] = t0[3] * cs[1] + t0[2] * sn[1];
                        v1[0] = t1[0] * cs[2] - t1[1] * sn[2]; v1[1] = t1[1] * cs[2] + t1[0] * sn[2];
                        v1[2] = t1[2] * cs[3] - t1[3] * sn[3]; v1[3] = t1[3] * cs[3] + t1[2] * sn[3];
                    }
                    v0 = v0 * QSCALE; v1 = v1 * QSCALE;
                    u32x4 w; w.x = cvtpk(v0[0], v0[1]); w.y = cvtpk(v0[2], v0[3]); w.z = cvtpk(v1[0], v1[1]); w.w = cvtpk(v1[2], v1[3]);
                    *(u32x4*)(O + (size_t)row * 1536 + col) = w;
                }
            }
    }
};

struct EpiLat {
    static constexpr bool AFTER_DRAIN = true;
    const float* qn; const float* kvn; const float* cosT; const float* sinT; bf16_t* CQ; bf16_t* CKV; bf16_t* CKV2; bf16_t* KR;
    DI void operator()(const f32x4 (&)[2][2][4][2], const Unit&, int, int, int, int) const {}
    DI void fused(const f32x4 (&acc)[2][2][4][2], const Unit& u, int wr, int wc, int fr, int fq, LAS unsigned char* lds) const {
        LAS float* P = (LAS float*)lds;
        const bool isq = (u.pn == 0);
#pragma unroll
        for (int ai = 0; ai < 2; ++ai)
#pragma unroll
            for (int m = 0; m < 4; ++m) {
                float s = 0.f;
#pragma unroll
                for (int n = 0; n < 2; ++n) { const f32x4 v = acc[ai][0][m][n]; s += (v[0] * v[0] + v[1] * v[1]) + (v[2] * v[2] + v[3] * v[3]); }
                if (isq) {
#pragma unroll
                    for (int n = 0; n < 2; ++n) { const f32x4 v = acc[ai][1][m][n]; s += (v[0] * v[0] + v[1] * v[1]) + (v[2] * v[2] + v[3] * v[3]); }
                }
                s += __shfl_xor(s, 16); s += __shfl_xor(s, 32);
                if (fq == 0) P[(ai * HALF + wr * 64 + m * 16 + fr) * 4 + wc] = s;
            }
        asm volatile("s_waitcnt lgkmcnt(0)" ::: "memory"); __builtin_amdgcn_s_barrier(); asm volatile("" ::: "memory");
        const float invn = isq ? (1.0f / 256) : (1.0f / 128);
        const int col0 = wc * 32 + 8 * fq;
#pragma unroll
        for (int ai = 0; ai < 2; ++ai)
#pragma unroll
            for (int m = 0; m < 4; ++m) {
                const int rl = ai * HALF + wr * 64 + m * 16 + fr, row = u.pm * BM + rl;
                const f32x4 pp = *(const LAS f32x4*)(P + rl * 4);
                const float rstd = 1.0f / sqrtf(((pp[0] + pp[1]) + (pp[2] + pp[3])) * invn + EPS);
                if (isq) {
#pragma unroll
                    for (int bj = 0; bj < 2; ++bj) {
                        const int col = col0 + bj * HALF;
                        const f32x4 g0 = *(const f32x4*)(qn + col), g1 = *(const f32x4*)(qn + col + 4);
                        const f32x4 v0 = (acc[ai][bj][m][0] * rstd) * g0, v1 = (acc[ai][bj][m][1] * rstd) * g1;
                        u32x4 w; w.x = cvtpk(v0[0], v0[1]); w.y = cvtpk(v0[2], v0[3]); w.z = cvtpk(v1[0], v1[1]); w.w = cvtpk(v1[2], v1[3]);
                        *(u32x4*)(CQ + (size_t)row * 256 + col) = w;
                    }
                } else {
                    {
                        const f32x4 g0 = *(const f32x4*)(kvn + col0), g1 = *(const f32x4*)(kvn + col0 + 4);
                        const f32x4 v0 = (acc[ai][0][m][0] * rstd) * g0, v1 = (acc[ai][0][m][1] * rstd) * g1;
                        u32x4 w; w.x = cvtpk(v0[0], v0[1]); w.y = cvtpk(v0[2], v0[3]); w.z = cvtpk(v1[0], v1[1]); w.w = cvtpk(v1[2], v1[3]);
                        *(u32x4*)(CKV + (size_t)row * 128 + col0) = w;
                        const int j = row & 15, prow = (row & ~15) + ((j >= 4 && j < 8) ? j + 4 : ((j >= 8 && j < 12) ? j - 4 : j));
                        *(u32x4*)(CKV2 + (size_t)prow * 128 + col0) = w;
                    }
                    if (wc == 0) {
                        const int s = row & (SEQ - 1);
                        const f32x4 cs = *(const f32x4*)(cosT + s * 16 + 4 * fq), sn = *(const f32x4*)(sinT + s * 16 + 4 * fq);
                        const f32x4 t0 = acc[ai][1][m][0], t1 = acc[ai][1][m][1];
                        u32x4 w;
                        w.x = cvtpk(t0[0] * cs[0] - t0[1] * sn[0], t0[1] * cs[0] + t0[0] * sn[0]);
                        w.y = cvtpk(t0[2] * cs[1] - t0[3] * sn[1], t0[3] * cs[1] + t0[2] * sn[1]);
                        w.z = cvtpk(t1[0] * cs[2] - t1[1] * sn[2], t1[1] * cs[2] + t1[0] * sn[2]);
                        w.w = cvtpk(t1[2] * cs[3] - t1[3] * sn[3], t1[3] * cs[3] + t1[2] * sn[3]);
                        *(u32x4*)(KR + (size_t)row * 32 + 8 * fq) = w;
                    }
                }
            }
        asm volatile("s_waitcnt lgkmcnt(0)" ::: "memory"); __builtin_amdgcn_s_barrier(); asm volatile("" ::: "memory");
    }
};

template <class Epi, bool ALIGN_EPI = true>
DI void gemm_phase(LAS unsigned char* lds, const Gemm g, const StaticOrder& S, const Epi& E) {
    int tid_ = threadIdx.x; asm volatile("" : "+v"(tid_));
    const int tid = tid_, wid = __builtin_amdgcn_readfirstlane(tid >> 6), lane = tid & 63, wr = wid >> 2, wc = wid & 3, fr = lane & 15, fq = lane >> 4;
    const int K = g.K, nt = K / BK;
    unsigned voffA[2], voffB[2];
#pragma unroll
    for (int i = 0; i < 2; ++i) { int R, C; stage_rc(tid * 16 + i * 8192, R, C); const int Rb = (R & ~31) + perm32(R & 31);
        voffA[i] = (unsigned)(R * K + C) * 2u; voffB[i] = (unsigned)(Rb * K + C) * 2u; }
    const size_t kstep = (size_t)(BK * 2);
    const size_t hstep = (size_t)HALF * K * 2;
    const size_t tstep = 2 * hstep;
    const unsigned ldsw = (unsigned)wid * 1024u;
    const int aoff = lds_byte(wr * 64 + fr, fq * 8), boff = lds_byte(wc * 32 + fr, fq * 8);
#define PG8_SA(b, h) (((b) * 2 + (h)) * HTB)
#define PG8_SB(b, h) ((4 + (b) * 2 + (h)) * HTB)
#define PG8_STAGE(bufoff, gbase, voff) do { _Pragma("unroll") for (int _i = 0; _i < 2; ++_i) { \
        unsigned vo_ = (voff)[_i]; asm volatile("" : "+v"(vo_));     \
        __builtin_amdgcn_global_load_lds((const unsigned*)((const char*)(gbase) + vo_), (LAS unsigned*)(lds + (bufoff) + ldsw + _i * 8192), 16, 0, 0); } } while (0)
#define PG8_LDA(dst, b, h) do { _Pragma("unroll") for (int m = 0; m < 4; ++m) _Pragma("unroll") for (int k = 0; k < 2; ++k) dst[m][k] = *(const LAS bf16x8*)(lds + PG8_SA(b, h) + aoff + m * 2048 + k * 1024); } while (0)
#define PG8_LDB(dst, b, h) do { _Pragma("unroll") for (int n = 0; n < 2; ++n) _Pragma("unroll") for (int k = 0; k < 2; ++k) dst[n][k] = *(const LAS bf16x8*)(lds + PG8_SB(b, h) + boff + n * 2048 + k * 1024); } while (0)
#define PG8_MMA(ai, bj, At, Bt) do { __builtin_amdgcn_s_setprio(1); _Pragma("unroll") for (int m = 0; m < 4; ++m) _Pragma("unroll") for (int n = 0; n < 2; ++n) _Pragma("unroll") for (int k = 0; k < 2; ++k) \
        acc[ai][bj][m][n] = __builtin_amdgcn_mfma_f32_16x16x32_bf16(Bt[n][k], At[m][k], acc[ai][bj][m][n], 0, 0, 0); __builtin_amdgcn_s_setprio(0); } while (0)
#define PG8_WAIT_V(n) asm volatile("s_waitcnt vmcnt(" #n ")" ::: "memory")
#define PG8_WAIT_L(n) asm volatile("s_waitcnt lgkmcnt(" #n ")" ::: "memory")
#define PG8_BAR __builtin_amdgcn_s_barrier()
#define PG8_SCHED __builtin_amdgcn_sched_barrier(0)
    Unit cur, nxt; int ui = 0;
    if (!S.next(0, cur)) return;
    f32x4 acc[2][2][4][2];
#pragma unroll
    for (int a = 0; a < 2; ++a)
#pragma unroll
        for (int b = 0; b < 2; ++b)
#pragma unroll
            for (int m = 0; m < 4; ++m)
#pragma unroll
                for (int n = 0; n < 2; ++n) acc[a][b][m][n] = (f32x4){0.f, 0.f, 0.f, 0.f};
    bf16x8 At[4][2], B0[2][2], B1[2][2];
    const char* cA = (const char*)g.A + (size_t)cur.pm * tstep + (size_t)cur.pn * g.a_pn_stride; const char* cB = (const char*)g.Bt + (size_t)cur.pn * tstep;
    PG8_STAGE(PG8_SB(0, 0), cB, voffB); PG8_STAGE(PG8_SB(0, 1), cB + hstep, voffB); PG8_STAGE(PG8_SA(0, 0), cA, voffA); PG8_STAGE(PG8_SA(0, 1), cA + hstep, voffA);
    if (wr == 1) PG8_BAR;
    PG8_WAIT_V(2); PG8_BAR;
    PG8_STAGE(PG8_SB(1, 0), cB + kstep, voffB); PG8_STAGE(PG8_SA(1, 0), cA + kstep, voffA); PG8_STAGE(PG8_SB(1, 1), cB + hstep + kstep, voffB);
    PG8_WAIT_V(6); PG8_BAR;
    for (;;) {
        const bool has_next = S.next(ui + 1, nxt);
        const char* nA = has_next ? (const char*)g.A + (size_t)nxt.pm * tstep + (size_t)nxt.pn * g.a_pn_stride : cA; const char* nB = has_next ? (const char*)g.Bt + (size_t)nxt.pn * tstep : cB;
        for (int t = 0; t < nt; t += 2) {
            const bool last = (t == nt - 2);
            const char* a1 = cA + (size_t)(t + 1) * kstep;
            const char* a2 = last ? nA : cA + (size_t)(t + 2) * kstep; const char* b2 = last ? nB : cB + (size_t)(t + 2) * kstep;
            const char* a3 = a2 + kstep; const char* b3 = b2 + kstep;
            PG8_LDB(B0, 0, 0); PG8_LDB(B1, 0, 1); PG8_SCHED; PG8_LDA(At, 0, 0); PG8_STAGE(PG8_SA(1, 1), a1 + hstep, voffA);
            PG8_WAIT_V(8); PG8_WAIT_L(0); PG8_BAR; PG8_MMA(0, 0, At, B0); PG8_MMA(0, 1, At, B1); PG8_BAR; PG8_SCHED;
            PG8_LDA(At, 0, 1); PG8_STAGE(PG8_SB(0, 0), b2, voffB); PG8_STAGE(PG8_SB(0, 1), b2 + hstep, voffB); PG8_STAGE(PG8_SA(0, 0), a2, voffA);
            PG8_WAIT_V(8); PG8_WAIT_L(0); PG8_BAR; PG8_MMA(1, 0, At, B0); PG8_MMA(1, 1, At, B1); PG8_BAR; PG8_SCHED;
            PG8_LDB(B0, 1, 0); PG8_LDB(B1, 1, 1); PG8_SCHED; PG8_LDA(At, 1, 0); PG8_STAGE(PG8_SA(0, 1), a2 + hstep, voffA);
            PG8_WAIT_V(8); PG8_WAIT_L(0); PG8_BAR; PG8_MMA(0, 0, At, B0); PG8_MMA(0, 1, At, B1); PG8_BAR; PG8_SCHED;
            PG8_LDA(At, 1, 1); PG8_STAGE(PG8_SB(1, 0), b3, voffB); PG8_STAGE(PG8_SB(1, 1), b3 + hstep, voffB); PG8_STAGE(PG8_SA(1, 0), a3, voffA);
            PG8_WAIT_V(8); PG8_WAIT_L(0); PG8_BAR; PG8_MMA(1, 0, At, B0); PG8_MMA(1, 1, At, B1); PG8_BAR; PG8_SCHED;
        }
        if constexpr (ALIGN_EPI) { if (wr == 0) PG8_BAR; }
        if constexpr (!Epi::AFTER_DRAIN) E(acc, cur, wr, wc, fr, fq);
        if (!has_next) break;
#pragma unroll
        for (int a = 0; a < 2; ++a)
#pragma unroll
            for (int b = 0; b < 2; ++b)
#pragma unroll
                for (int m = 0; m < 4; ++m)
#pragma unroll
                    for (int n = 0; n < 2; ++n) acc[a][b][m][n] = (f32x4){0.f, 0.f, 0.f, 0.f};
        cur = nxt; cA = nA; cB = nB; ++ui;
        if constexpr (ALIGN_EPI) { if (wr == 1) PG8_BAR; }
    }
    PG8_WAIT_V(0);
    if constexpr (!ALIGN_EPI) { if (wr == 0) PG8_BAR; }
    PG8_BAR;
    if constexpr (Epi::AFTER_DRAIN) E.fused(acc, cur, wr, wc, fr, fq, lds);
#undef PG8_SA
#undef PG8_SB
#undef PG8_STAGE
#undef PG8_LDA
#undef PG8_LDB
#undef PG8_MMA
#undef PG8_WAIT_V
#undef PG8_WAIT_L
#undef PG8_BAR
#undef PG8_SCHED
}
}

DI int rowmap(int mode, int n) {
    if (mode == 1) { const int up = n >= FF ? 1 : 0, j = n - up * FF; return (j >> 7) * 256 + up * 128 + (j & 127); }
    if (mode == 2) { const int h = n / 96, d = n - h * 96; if (d < 64) return n; if (d < 80) return h * 96 + 64 + 2 * (d - 64); return h * 96 + 64 + 2 * (d - 80) + 1; }
    if (mode == 3) { if (n < 384) return n; if (n < 400) return 384 + 2 * (n - 384); return 384 + 2 * (n - 400) + 1; }
    return n;
}
DI void transpose_item(const float* W, int K, int N, bf16_t* WT, int mode, int row_off, LAS float* scr, int item, int lane) {
    const int nblk = N / 32, kb = item / nblk, nb = item - kb * nblk, k0 = 64 * kb, n0 = 32 * nb;
#pragma unroll 8
    for (int i = 0; i < 32; ++i) { const int kk = 2 * i + (lane >> 5); scr[kk * 33 + (lane & 31)] = __builtin_nontemporal_load(&W[(size_t)(k0 + kk) * N + n0 + (lane & 31)]); }
    asm volatile("s_waitcnt lgkmcnt(0)" ::: "memory");
    const int c = lane & 7;
#pragma unroll
    for (int j = 0; j < 4; ++j) { const int n = (lane >> 3) + 8 * j; const LAS float* s = scr + (8 * c) * 33 + n;
        u32x4 o; o.x = cvtpk(s[0 * 33], s[1 * 33]); o.y = cvtpk(s[2 * 33], s[3 * 33]); o.z = cvtpk(s[4 * 33], s[5 * 33]); o.w = cvtpk(s[6 * 33], s[7 * 33]);
        *(u32x4*)(WT + (size_t)(row_off + rowmap(mode, n0 + n)) * K + k0 + 8 * c) = o; }
    asm volatile("s_waitcnt lgkmcnt(0)" ::: "memory");
}
DI void ada_item(const float* ada_w, const float* ada_b, float* mod, const LAS float* sc, int item, int lane) {
    const int l = item / 288, n0 = (item - l * 288) * 32, cgp = lane & 7, kr = lane >> 3;
    const float* W = ada_w + (size_t)l * 1024 * 9216 + n0 + 4 * cgp;
    float acc[8][4];
#pragma unroll
    for (int b = 0; b < 8; ++b)
#pragma unroll
        for (int e = 0; e < 4; ++e) acc[b][e] = 0.f;
    for (int k = kr; k < 1024; k += 64) {
        f32x4 w[8];
#pragma unroll
        for (int u = 0; u < 8; ++u) w[u] = __builtin_nontemporal_load((const f32x4*)(W + (size_t)(k + 8 * u) * 9216));
#pragma unroll
        for (int u = 0; u < 8; ++u) {
            const f32x4 s0 = *(const LAS f32x4*)(sc + (k + 8 * u) * 8), s1 = *(const LAS f32x4*)(sc + (k + 8 * u) * 8 + 4);
#pragma unroll
            for (int e = 0; e < 4; ++e) {
                acc[0][e] += s0[0] * w[u][e]; acc[1][e] += s0[1] * w[u][e]; acc[2][e] += s0[2] * w[u][e]; acc[3][e] += s0[3] * w[u][e];
                acc[4][e] += s1[0] * w[u][e]; acc[5][e] += s1[1] * w[u][e]; acc[6][e] += s1[2] * w[u][e]; acc[7][e] += s1[3] * w[u][e];
            }
        }
    }
#pragma unroll
    for (int b = 0; b < 8; ++b)
#pragma unroll
        for (int e = 0; e < 4; ++e) { float v = acc[b][e]; v += __shfl_xor(v, 8); v += __shfl_xor(v, 16); v += __shfl_xor(v, 32); acc[b][e] = v; }
    if (kr == 0) {
        const f32x4 bias = *(const f32x4*)(ada_b + l * 9216 + n0 + 4 * cgp);
#pragma unroll
        for (int b = 0; b < 8; ++b) { f32x4 o = {acc[b][0] + bias[0], acc[b][1] + bias[1], acc[b][2] + bias[2], acc[b][3] + bias[3]}; *(f32x4*)(mod + (size_t)(l * 8 + b) * 9216 + n0 + 4 * cgp) = o; }
    }
}
DI void rope_entry(float* cosT, float* sinT, int idx) {
    const int s = idx >> 4, j = idx & 15, jq = j & 3;
    double pw = jq == 0 ? 1.0 : (jq == 1 ? 1.7782794100389228 : (jq == 2 ? 3.1622776601683795 : 5.623413251903491));
    const int dec = j >> 2; pw *= dec == 0 ? 1.0 : (dec == 1 ? 10.0 : (dec == 2 ? 100.0 : 1000.0));
    const float inv = 1.0f / (float)pw;
    const float ang = (float)s * inv;
    const double a = (double)ang;
    const double kq = __builtin_rint(a * 0.63661977236758134308);
    const double t = (a - kq * 1.5707963267948966192) - kq * 6.123233995736766036e-17;
    const double t2 = t * t;
    const double sn = t * (1.0 + t2 * (-1.0 / 6 + t2 * (1.0 / 120 + t2 * (-1.0 / 5040 + t2 * (1.0 / 362880 + t2 * (-1.0 / 39916800 + t2 * (1.0 / 6227020800.0)))))));
    const double cs = 1.0 + t2 * (-0.5 + t2 * (1.0 / 24 + t2 * (-1.0 / 720 + t2 * (1.0 / 40320 + t2 * (-1.0 / 3628800 + t2 * (1.0 / 479001600.0))))));
    const int q = (int)((long long)kq & 3);
    const double c = q == 0 ? cs : (q == 1 ? -sn : (q == 2 ? -cs : sn));
    const double sv = q == 0 ? sn : (q == 1 ? cs : (q == 2 ? -sn : -cs));
    cosT[idx] = (float)c; sinT[idx] = (float)sv;
}

template <bool POST, bool PRE, bool STOREX, bool XIB, bool XOB>
DI void rows_range(const void* xin, void* xout, const bf16_t* Y, const float* gpost, const float* gate, float w,
                   const float* gpre, const float* shift, const float* scale, bf16_t* Hout, int row0, int rpw, int lane) {
    const int b = row0 >> 12;
    f32x4 ca[4], cb[4], cs[4];
#pragma unroll
    for (int j = 0; j < 4; ++j) {
        if (POST) { const f32x4 gp = ((const f32x4*)gpost)[lane + 64 * j], gt = ((const f32x4*)(gate + (size_t)b * 9216))[lane + 64 * j]; ca[j] = (w * (1.0f + gt)) * gp; }
        if (PRE) { const f32x4 gp = ((const f32x4*)gpre)[lane + 64 * j], sc = ((const f32x4*)(scale + (size_t)b * 9216))[lane + 64 * j]; cb[j] = gp * (1.0f + sc); cs[j] = ((const f32x4*)(shift + (size_t)b * 9216))[lane + 64 * j]; }
    }
    for (int r = 0; r < rpw; r += 2) {
        f32x4 x[2][4]; u32x2 yb[2][4];
#pragma unroll
        for (int q = 0; q < 2; ++q) {
            const int row = row0 + r + q;
            if (XIB) { const u32x2* xr = (const u32x2*)((const bf16_t*)xin + (size_t)row * DM) + lane;
#pragma unroll
                for (int j = 0; j < 4; ++j) { const u32x2 t = __builtin_nontemporal_load(&xr[64 * j]); x[q][j] = (f32x4){bflo(t.x), bfhi(t.x), bflo(t.y), bfhi(t.y)}; } }
            else { const f32x4* xr = (const f32x4*)((const float*)xin + (size_t)row * DM) + lane;
#pragma unroll
                for (int j = 0; j < 4; ++j) x[q][j] = __builtin_nontemporal_load(&xr[64 * j]); }
            if (POST) { const u32x2* yr = (const u32x2*)(Y + (size_t)row * DM) + lane;
#pragma unroll
                for (int j = 0; j < 4; ++j) yb[q][j] = __builtin_nontemporal_load(&yr[64 * j]); }
        }
#pragma unroll
        for (int q = 0; q < 2; ++q) {
            const int row = row0 + r + q;
            if (POST) {
                f32x4 y[4]; float ss = 0.f;
#pragma unroll
                for (int j = 0; j < 4; ++j) { const u32x2 t = yb[q][j]; y[j] = (f32x4){bflo(t.x), bfhi(t.x), bflo(t.y), bfhi(t.y)}; ss += (y[j][0] * y[j][0] + y[j][1] * y[j][1]) + (y[j][2] * y[j][2] + y[j][3] * y[j][3]); }
                const float rstd = 1.0f / sqrtf(wave_sum(ss) * (1.0f / DM) + EPS);
#pragma unroll
                for (int j = 0; j < 4; ++j) x[q][j] = x[q][j] + ca[j] * (y[j] * rstd);
                if (STOREX) {
                    if (XOB) { u32x2* xo = (u32x2*)((bf16_t*)xout + (size_t)row * DM) + lane;
#pragma unroll
                        for (int j = 0; j < 4; ++j) { u32x2 o; o.x = cvtpk(x[q][j][0], x[q][j][1]); o.y = cvtpk(x[q][j][2], x[q][j][3]); __builtin_nontemporal_store(o, &xo[64 * j]); } }
                    else { f32x4* xo = (f32x4*)((float*)xout + (size_t)row * DM) + lane;
#pragma unroll
                        for (int j = 0; j < 4; ++j) xo[64 * j] = x[q][j]; }
                }
            }
            if (PRE) {
                float ss = 0.f;
#pragma unroll
                for (int j = 0; j < 4; ++j) ss += (x[q][j][0] * x[q][j][0] + x[q][j][1] * x[q][j][1]) + (x[q][j][2] * x[q][j][2] + x[q][j][3] * x[q][j][3]);
                const float rstd = 1.0f / sqrtf(wave_sum(ss) * (1.0f / DM) + EPS);
                u32x2* ho = (u32x2*)(Hout + (size_t)row * DM) + lane;
#pragma unroll
                for (int j = 0; j < 4; ++j) { const f32x4 h = (x[q][j] * rstd) * cb[j] + cs[j]; u32x2 o; o.x = cvtpk(h[0], h[1]); o.y = cvtpk(h[2], h[3]); ho[64 * j] = o; }
            }
        }
    }
}
template <bool POST, bool PRE, bool XIB, bool XOB>
DI void rows_phase(const void* xin, void* xout, const bf16_t* Y, const float* gpost, const float* gate, float w,
                   const float* gpre, const float* shift, const float* scale, bf16_t* Hout, int vcu, int G) {
    const int tid = opaque_tid(), lane = tid & 63, gw = vcu * 8 + __builtin_amdgcn_readfirstlane(tid >> 6), ngw = G * 8, rpw = MT / ngw;
    rows_range<POST, PRE, true, XIB, XOB>(xin, xout, Y, gpost, gate, w, gpre, shift, scale, Hout, gw * rpw, rpw, lane);
}
DI void lat_rows_phase(const float* LAT, const float* qn, const float* kvn, const float* cosT, const float* sinT, bf16_t* CQ, bf16_t* CKV, bf16_t* CKV2, bf16_t* KR, int vcu, int G) {
    const int tid = opaque_tid(), lane = tid & 63, gw = vcu * 8 + __builtin_amdgcn_readfirstlane(tid >> 6), ngw = G * 8;
    for (int row = gw; row < MT; row += ngw) {
        const float* lr = LAT + (size_t)row * 512;
        const f32x4 q = ((const f32x4*)lr)[lane];
        const f32x4 kv = ((const f32x4*)(lr + 256))[lane & 31];
        float sq = (q[0] * q[0] + q[1] * q[1]) + (q[2] * q[2] + q[3] * q[3]);
        float sk = (kv[0] * kv[0] + kv[1] * kv[1]) + (kv[2] * kv[2] + kv[3] * kv[3]);
        sq = wave_sum(sq);
#pragma unroll
        for (int o = 1; o < 32; o <<= 1) sk += __shfl_xor(sk, o);
        const float rq = 1.0f / sqrtf(sq * (1.0f / 256) + EPS), rk = 1.0f / sqrtf(sk * (1.0f / 128) + EPS);
        const f32x4 gq = ((const f32x4*)qn)[lane], gk = ((const f32x4*)kvn)[lane & 31];
        const f32x4 cq = (q * rq) * gq, ck = (kv * rk) * gk;
        u32x2 o; o.x = cvtpk(cq[0], cq[1]); o.y = cvtpk(cq[2], cq[3]); ((u32x2*)(CQ + (size_t)row * 256))[lane] = o;
        if (lane < 32) { u32x2 p; p.x = cvtpk(ck[0], ck[1]); p.y = cvtpk(ck[2], ck[3]); ((u32x2*)(CKV + (size_t)row * 128))[lane] = p;
            const int j = row & 15, prow = (row & ~15) + ((j >= 4 && j < 8) ? j + 4 : ((j >= 8 && j < 12) ? j - 4 : j));
            ((u32x2*)(CKV2 + (size_t)prow * 128))[lane] = p; }
        if (lane < 16) {
            const int s = row & (SEQ - 1);
            const float x1 = lr[384 + 2 * lane], x2 = lr[385 + 2 * lane], cs = cosT[s * 16 + lane], sn = sinT[s * 16 + lane];
            ((unsigned*)(KR + (size_t)row * 32))[lane] = cvtpk(x1 * cs - x2 * sn, x2 * cs + x1 * sn);
        }
    }
}
template <int W>
DI void pool_chunk(const bf16_t* H, bf16_t* PD, int b, int t0, int tid) {
    constexpr int HW = W / 2, NR = 32 + W - 1;
    const unsigned* src = (const unsigned*)(H + (size_t)b * SEQ * DM) + tid;
    float lo[NR], hi[NR];
#pragma unroll
    for (int i = 0; i < NR; ++i) { const int t = t0 - HW + i; unsigned v = 0u; if (t >= 0 && t < SEQ) v = src[(size_t)t * 512]; lo[i] = bflo(v); hi[i] = bfhi(v); }
    const int g = tid >> 7, c2 = tid & 127;
    unsigned* dst = (unsigned*)(PD + ((size_t)g * MT + (size_t)b * SEQ) * 256) + c2;
#pragma unroll
    for (int i = 0; i < 32; ++i) {
        const int t = t0 + i; int l0 = t - HW, h0 = t + HW; l0 = l0 < 0 ? 0 : l0; h0 = h0 > SEQ ? SEQ : h0;
        float sl = 0.f, sh = 0.f;
#pragma unroll
        for (int k = 0; k < W; ++k) { sl += lo[i + k]; sh += hi[i + k]; }
        const float inv = 1.0f / (float)(h0 - l0);
        dst[(size_t)t * 128] = cvtpk(sl * inv - lo[i + HW], sh * inv - hi[i + HW]);
    }
}

namespace att {
constexpr int KROW = 208, VROW = 144, KBUF = 64 * KROW, VBUF = 64 * VROW;
constexpr float THR = 8.0f;
#define SBAR() __builtin_amdgcn_sched_barrier(0)
#define MFMA32(a, b, c) __builtin_amdgcn_mfma_f32_32x32x16_bf16((a), (b), (c), 0, 0, 0)
DI float xhalf_max(float m) { auto rr = __builtin_amdgcn_permlane32_swap(__float_as_uint(m), __float_as_uint(m), false, false); return fmaxf(__uint_as_float(rr[0]), __uint_as_float(rr[1])); }
DI float xhalf_sum(float m) { auto rr = __builtin_amdgcn_permlane32_swap(__float_as_uint(m), __float_as_uint(m), false, false); return __uint_as_float(rr[0]) + __uint_as_float(rr[1]); }
template <int G> DI void valu_a(const f32x16& P0, const f32x16& P1, float& sacc, u32x4 (&pw)[4]) {
    constexpr int e0 = G * 32 / 12, e1 = (G + 1) * 32 / 12, c0 = G * 16 / 12, c1 = (G + 1) * 16 / 12;
#pragma unroll
    for (int e = e0; e < e1; ++e) sacc += (e < 16 ? P0[e & 15] : P1[e & 15]);
#pragma unroll
    for (int c = c0; c < c1; ++c) { const float lo = (c < 8 ? P0[(2 * c) & 15] : P1[(2 * c) & 15]), hi = (c < 8 ? P0[(2 * c + 1) & 15] : P1[(2 * c + 1) & 15]); pw[c >> 2][c & 3] = cvtpk(lo, hi); }
}
template <int B> DI void exp4(f32x16& X) { X[B] = __builtin_amdgcn_exp2f(X[B]); X[B + 1] = __builtin_amdgcn_exp2f(X[B + 1]); X[B + 2] = __builtin_amdgcn_exp2f(X[B + 2]); X[B + 3] = __builtin_amdgcn_exp2f(X[B + 3]); }
DI float max3f(float a, float b, float c) { float r; asm("v_max3_f32 %0, %1, %2, %3" : "=v"(r) : "v"(a), "v"(b), "v"(c)); return r; }
DI float max16x2(const f32x16& a, const f32x16& b) {
    float m0 = max3f(a[0], a[1], b[0]), m1 = max3f(a[2], a[3], b[1]); m0 = max3f(m0, b[2], b[3]);
#pragma unroll
    for (int r = 4; r < 16; r += 4) { m0 = max3f(m0, a[r], a[r + 1]); m1 = max3f(m1, a[r + 2], a[r + 3]); m0 = max3f(m0, b[r], b[r + 1]); m1 = max3f(m1, b[r + 2], b[r + 3]); }
    return max3f(m0, m1, m1);
}
DI bf16x8 vfrag(const LAS unsigned char* p) { return *(const LAS bf16x8*)p; }

constexpr int NS = 6, STG = KBUF + VBUF;
DI void unit(LAS unsigned char* lds, const bf16_t* Q, const bf16_t* KN, const bf16_t* KR, const bf16_t* VT, bf16_t* O, int b, int h, int qb) {
    const int tid = opaque_tid(), lane = tid & 63, wid = __builtin_amdgcn_readfirstlane(tid >> 6), r32 = lane & 31, hi = lane >> 5;
    const size_t tok0 = (size_t)b * SEQ;
    const char* gp[3]; unsigned gstep[3]; int loff[3];
#pragma unroll
    for (int i = 0; i < 3; ++i) {
        const int j = wid * 3 + i;
        if (j < 13) {
            const int c = 64 * j + lane, row = c / 13, col = c - 13 * row;
            if (col >= 8 && col < 12) { gp[i] = (const char*)(KR + (tok0 + row) * 32 + 8 * (col - 8)); gstep[i] = 64u * 32u * 2u; }
            else { gp[i] = (const char*)(KN + (tok0 + row) * 1024 + h * 64 + 8 * (col & 7)); gstep[i] = 64u * 1024u * 2u; }
            loff[i] = j * 1024;
        } else {
            const int jj = j < 22 ? j - 13 : j - 22, c = 64 * jj + lane, row = c / 9, col = c - 9 * row;
            gp[i] = (const char*)(VT + (size_t)(h * 64 + row) * MT + tok0 + 8 * (col & 7)); gstep[i] = 128u;
            loff[i] = KBUF + jj * 1024;
        }
    }
#define DMA_TILE(T) do { const int tt_ = (T) < SEQ / 64 ? (T) : SEQ / 64 - 1; const int sl_ = (T) % NS; \
    _Pragma("unroll") for (int i_ = 0; i_ < 3; ++i_) \
        __builtin_amdgcn_global_load_lds((const unsigned*)(gp[i_] + (size_t)tt_ * gstep[i_]), (LAS unsigned*)(lds + sl_ * STG + loff[i_]), 16, 0, 0); } while (0)
#define WAIT_BAR(N) do { asm volatile("s_waitcnt vmcnt(" #N ") lgkmcnt(0)" ::: "memory"); __builtin_amdgcn_s_barrier(); asm volatile("" ::: "memory"); } while (0)
    const int kofs = r32 * KROW + 16 * hi, vofs = KBUF + r32 * VROW + 16 * hi;
    DMA_TILE(0); DMA_TILE(1); DMA_TILE(2); DMA_TILE(3);
    const bf16_t* qp = Q + (tok0 + qb * 256 + wid * 32 + r32) * 1536 + h * 96 + 8 * hi;
    bf16x8 qf[6];
#pragma unroll
    for (int d0 = 0; d0 < 6; ++d0) qf[d0] = __builtin_nontemporal_load((const bf16x8*)(qp + 16 * d0));
    f32x16 o0, o1, negm, pA0, pA1, pB0, pB1;
#pragma unroll
    for (int r = 0; r < 16; ++r) { o0[r] = 0.f; o1[r] = 0.f; negm[r] = 0.f; }
    float mhat = 0.f, lrun = 0.f;
    asm volatile("s_waitcnt vmcnt(0)" ::: "memory");
    __builtin_amdgcn_s_barrier(); asm volatile("" ::: "memory");
    DMA_TILE(4);
    bf16x8 kf[12], vf[8];
    {
        const LAS unsigned char* kb = lds + kofs;
#pragma unroll
        for (int d0 = 0; d0 < 6; ++d0) { kf[2 * d0] = *(const LAS bf16x8*)(kb + 32 * d0); kf[2 * d0 + 1] = *(const LAS bf16x8*)(kb + 32 * KROW + 32 * d0); }
#pragma unroll
        for (int d0 = 0; d0 < 6; ++d0) { pA0 = MFMA32(kf[2 * d0], qf[d0], d0 == 0 ? negm : pA0); pA1 = MFMA32(kf[2 * d0 + 1], qf[d0], d0 == 0 ? negm : pA1); }
        mhat = xhalf_max(max16x2(pA0, pA1));
#pragma unroll
        for (int r = 0; r < 16; ++r) { pA0[r] = __builtin_amdgcn_exp2f(pA0[r] - mhat); pA1[r] = __builtin_amdgcn_exp2f(pA1[r] - mhat); negm[r] = -mhat; }
        const LAS unsigned char* kb1 = lds + STG + kofs;
#pragma unroll
        for (int d0 = 0; d0 < 6; ++d0) { kf[2 * d0] = *(const LAS bf16x8*)(kb1 + 32 * d0); kf[2 * d0 + 1] = *(const LAS bf16x8*)(kb1 + 32 * KROW + 32 * d0); }
    }
    WAIT_BAR(3);
#define PIN(x) asm volatile("" : "+v"(x))
#define VRD(i) vf[i] = *(const LAS bf16x8*)(vb + ((i) & 1) * 32 * VROW + ((i) >> 1) * 32)
#define KRD(i) kf[i] = *(const LAS bf16x8*)(kbn + ((i) & 1) * 32 * KROW + ((i) >> 1) * 32)
#define QKSTEP(C0, C1, P0, P1, d0, G0, G1) \
    if (G0 < 8) VRD(G0); \
    C0 = MFMA32(kf[2 * d0], qf[d0], d0 == 0 ? negm : C0); valu_a<G0>(P0, P1, sacc, pw); PIN(sacc); PIN(pw[(G0 * 16 / 12) >> 2]); SBAR(); \
    if (G1 < 8) VRD(G1); \
    C1 = MFMA32(kf[2 * d0 + 1], qf[d0], d0 == 0 ? negm : C1); valu_a<G1>(P0, P1, sacc, pw); PIN(sacc); PIN(pw[(G1 * 16 / 12) >> 2]); SBAR();
#define PVSTEP(ks, X, B) \
    if (ks < 2) { KRD(4 * ks); KRD(4 * ks + 1); } else { KRD(2 * ks + 4); } \
    o0 = MFMA32(vf[2 * ks], __builtin_bit_cast(bf16x8, pw[ks]), o0); exp4<B>(X); PIN(X); SBAR(); \
    if (ks < 2) { KRD(4 * ks + 2); KRD(4 * ks + 3); } else { KRD(2 * ks + 5); } \
    o1 = MFMA32(vf[2 * ks + 1], __builtin_bit_cast(bf16x8, pw[ks]), o1); exp4<B + 4>(X); PIN(X); SBAR();
#define STEP(C0, C1, P0, P1, T, DOMAX) do { \
    const int t_ = (T); \
    DMA_TILE(t_ + 4); \
    const LAS unsigned char* vb = lds + ((t_ - 1) % NS) * STG + vofs; \
    const LAS unsigned char* kbn = lds + ((t_ + 1) % NS) * STG + kofs; \
    asm volatile("" : "+v"(vb), "+v"(kbn));     \
    float sacc = 0.f; u32x4 pw[4]; \
    SBAR(); __builtin_amdgcn_s_setprio(1); \
    QKSTEP(C0, C1, P0, P1, 0, 0, 1) QKSTEP(C0, C1, P0, P1, 1, 2, 3) QKSTEP(C0, C1, P0, P1, 2, 4, 5) \
    QKSTEP(C0, C1, P0, P1, 3, 6, 7) QKSTEP(C0, C1, P0, P1, 4, 8, 9) QKSTEP(C0, C1, P0, P1, 5, 10, 11) \
    __builtin_amdgcn_s_setprio(0); lrun += sacc; \
    float rm = 0.f; if (DOMAX) rm = xhalf_max(max16x2(C0, C1));     \
    SBAR(); \
    PVSTEP(0, C0, 0) PVSTEP(1, C0, 8) PVSTEP(2, C1, 0) PVSTEP(3, C1, 8) \
    WAIT_BAR(6); \
    if (DOMAX) if (__builtin_expect(__any(rm > THR), 0)) { const float dl = fmaxf(rm, 0.f), fres = __builtin_amdgcn_exp2f(-dl); mhat += dl; lrun *= fres; \
        _Pragma("unroll") for (int r = 0; r < 16; ++r) { C0[r] *= fres; C1[r] *= fres; o0[r] *= fres; o1[r] *= fres; negm[r] = -mhat; } \
        PIN(C0); PIN(C1); PIN(o0); PIN(o1); PIN(negm); } \
    } while (0)
    int t = 1;
    for (; t + 1 < SEQ / 64; t += 2) {
        STEP(pB0, pB1, pA0, pA1, t, true);
        STEP(pA0, pA1, pB0, pB1, t + 1, false);
    }
    STEP(pB0, pB1, pA0, pA1, SEQ / 64 - 1, true);
    {
        float sacc = 0.f; u32x4 pw[4];
        valu_a<0>(pB0, pB1, sacc, pw); valu_a<1>(pB0, pB1, sacc, pw); valu_a<2>(pB0, pB1, sacc, pw); valu_a<3>(pB0, pB1, sacc, pw);
        valu_a<4>(pB0, pB1, sacc, pw); valu_a<5>(pB0, pB1, sacc, pw); valu_a<6>(pB0, pB1, sacc, pw); valu_a<7>(pB0, pB1, sacc, pw);
        valu_a<8>(pB0, pB1, sacc, pw); valu_a<9>(pB0, pB1, sacc, pw); valu_a<10>(pB0, pB1, sacc, pw); valu_a<11>(pB0, pB1, sacc, pw);
        lrun += sacc;
        const LAS unsigned char* vb = lds + ((SEQ / 64 - 1) % NS) * STG + vofs;
#pragma unroll
        for (int ks = 0; ks < 4; ++ks) {
            o0 = MFMA32(vfrag(vb + 32 * ks), __builtin_bit_cast(bf16x8, pw[ks]), o0);
            o1 = MFMA32(vfrag(vb + 32 * VROW + 32 * ks), __builtin_bit_cast(bf16x8, pw[ks]), o1);
        }
    }
#undef STEP
#undef QKSTEP
#undef PVSTEP
#undef PIN
#undef VRD
#undef KRD
    const float inv = 1.0f / xhalf_sum(lrun);
    bf16_t* orow = O + (tok0 + qb * 256 + wid * 32 + r32) * 1024 + h * 64 + 8 * hi;
#pragma unroll
    for (int dt = 0; dt < 2; ++dt)
#pragma unroll
        for (int g = 0; g < 4; g += 2) {
            const f32x16& oo = dt == 0 ? o0 : o1;
            u32x2 a, b;
            a.x = cvtpk(oo[4 * g] * inv, oo[4 * g + 1] * inv); a.y = cvtpk(oo[4 * g + 2] * inv, oo[4 * g + 3] * inv);
            b.x = cvtpk(oo[4 * g + 4] * inv, oo[4 * g + 5] * inv); b.y = cvtpk(oo[4 * g + 6] * inv, oo[4 * g + 7] * inv);
            { auto r = __builtin_amdgcn_permlane32_swap(a.x, b.x, false, false); a.x = r[0]; b.x = r[1]; }
            { auto r = __builtin_amdgcn_permlane32_swap(a.y, b.y, false, false); a.y = r[0]; b.y = r[1]; }
            u32x4 w; w.x = a.x; w.y = a.y; w.z = b.x; w.w = b.y;
            *(u32x4*)(orow + 32 * dt + 8 * g) = w;
        }
    WAIT_BAR(0);
#undef DMA_TILE
#undef WAIT_BAR
}
#undef SBAR
#undef MFMA32
}

typedef __attribute__((address_space(1))) unsigned gu32;
#define RLX_AGENT __ATOMIC_RELAXED, __HIP_MEMORY_SCOPE_AGENT
#define XB_TMO      128
#define XB_XCNT(j)  (256  + 64 * (j))
#define XB_XSUB(j)  (1280 + 64 * (j))
#define XB_XGEN(j)  (2304 + 64 * (j))
#define XB_TOP      3328
#define XB_TOPGEN   3392
#define XCD_BAR_WORDS 3456
#define XB_SPIN_CAP (1u << 18)

__device__ __forceinline__ unsigned xb_ld(unsigned* p)              { return __hip_atomic_load(p, __ATOMIC_RELAXED, __HIP_MEMORY_SCOPE_AGENT); }
__device__ __forceinline__ unsigned xb_add(unsigned* p, unsigned v) { return __hip_atomic_fetch_add(p, v, __ATOMIC_RELAXED, __HIP_MEMORY_SCOPE_AGENT); }
__device__ __forceinline__ unsigned xb_xcc_id() { return (unsigned)__builtin_amdgcn_s_getreg((3 << 11) | 20) & 0xFu; }
#define XB_SPIN(cond, bar) do { unsigned _sp = 0; while (cond) { __builtin_amdgcn_s_sleep(1); \
    if ((++_sp & 255u) == 0u) { if (xb_ld(&(bar)[XB_TMO])) break; if (_sp > XB_SPIN_CAP) { atomicAdd(&(bar)[XB_TMO], 1u); break; } } } } while (0)

struct XcdBarrier {
    unsigned* bar; unsigned x;
    volatile LAS unsigned* st;
};

__device__ __forceinline__ XcdBarrier xcd_barrier_post(unsigned* bar, volatile LAS unsigned* st) {
    XcdBarrier b; b.bar = bar; b.x = xb_xcc_id(); b.st = st;
    if (threadIdx.x == 0) (void)xb_add(&bar[XB_XCNT(b.x)], 1u);
    return b;
}
__device__ __forceinline__ void xcd_barrier_complete(unsigned* bar, unsigned x, unsigned& nloc, unsigned& nx) {
    const unsigned G = gridDim.x * gridDim.y * gridDim.z;
    unsigned sum, cnt, mine, sp = 0u;
    for (;;) {
        sum = 0u; cnt = 0u; mine = 0u;
#pragma unroll
        for (unsigned j = 0; j < 16; ++j) { const unsigned c = xb_ld(&bar[XB_XCNT(j)]); sum += c; cnt += (c > 0u) ? 1u : 0u; mine = (j == x) ? c : mine; }
        if (sum == G) break;
        __builtin_amdgcn_s_sleep(1);
        if ((++sp & 255u) == 0u) { if (xb_ld(&bar[XB_TMO])) break; if (sp > XB_SPIN_CAP) { atomicAdd(&bar[XB_TMO], 1u); break; } }
    }
    nloc = mine > 0u ? mine : 1u; nx = cnt > 0u ? cnt : 1u;
}

__device__ __forceinline__ void xcd_barrier(const XcdBarrier& b) {
    asm volatile("s_waitcnt vmcnt(0)" ::: "memory");
    __syncthreads();
    if (threadIdx.x == 0) {
        unsigned* bar = b.bar;
        __builtin_amdgcn_s_waitcnt(0);
        unsigned nloc = b.st[0], nx = b.st[1];
        if (nloc == 0u) { xcd_barrier_complete(bar, b.x, nloc, nx); b.st[0] = nloc; b.st[1] = nx; }
        const unsigned old = xb_add(&bar[XB_XSUB(b.x)], 1u);
        const unsigned gen = old / nloc;
        if (old + 1u == (gen + 1u) * nloc) {
            __builtin_amdgcn_fence(__ATOMIC_RELEASE, "agent");
            asm volatile("s_waitcnt vmcnt(0)" ::: "memory");
            const unsigned og = xb_add(&bar[XB_TOP], 1u);
            const unsigned tg = og / nx;
            if (og + 1u == (tg + 1u) * nx) xb_add(&bar[XB_TOPGEN], 1u);
            else XB_SPIN(xb_ld(&bar[XB_TOPGEN]) == tg, bar);
            __builtin_amdgcn_fence(__ATOMIC_ACQUIRE, "agent");
            xb_add(&bar[XB_XGEN(b.x)], 1u);
            asm volatile("s_waitcnt vmcnt(0)" ::: "memory");
        } else {
            XB_SPIN(xb_ld(&bar[XB_XGEN(b.x)]) == gen, bar);
            __builtin_amdgcn_fence(__ATOMIC_ACQUIRE, "agent");
            asm volatile("s_waitcnt vmcnt(0)" ::: "memory");
        }
    }
    __syncthreads();
}

struct Args { const float* in[17]; float* out; unsigned char* ws; };
__global__ void __launch_bounds__(512, 2) fwd_megakernel(Args a) {
    extern __shared__ __attribute__((aligned(16))) unsigned char lds_raw[];
    LAS unsigned char* lds = (LAS unsigned char*)lds_raw;
    cg::grid_group grid = cg::this_grid();
    const int G = gridDim.x, bx = blockIdx.x;
    const int vcu = (G % 8 == 0) ? (bx % 8) * (G / 8) + bx / 8 : bx;
    unsigned char* ws = a.ws;
    const float* x_in = a.in[0]; const float* c_in = a.in[1]; const float* ada_w = a.in[2]; const float* ada_b = a.in[3]; const float* norm_g = a.in[4];
    const float* ffn_w_in = a.in[5]; const float* ffn_w_out = a.in[6]; const float* pool_w = a.in[7]; const float* pool_b = a.in[8]; const float* pool_scale = a.in[9];
    const float* mla_w_in = a.in[10]; const float* mla_q_norm = a.in[11]; const float* mla_kv_norm = a.in[12]; const float* mla_w_uq = a.in[13];
    const float* mla_w_uk = a.in[14]; const float* mla_w_uv = a.in[15]; const float* mla_w_o = a.in[16];
    float* X = a.out;
    bf16_t* XB = (bf16_t*)a.out;
    bf16_t* XB2 = (bf16_t*)(ws + WS_KN);
    float* mod = (float*)(ws + WS_MOD);
    float* cosT = (float*)(ws + WS_ROPE); float* sinT = cosT + SEQ * 16;
    bf16_t* Hb = (bf16_t*)(ws + WS_H); bf16_t* Yb = (bf16_t*)(ws + WS_Y); bf16_t* ACT = (bf16_t*)(ws + WS_ACT);
    bf16_t* Wp_t = (bf16_t*)(ws + WS_WP); bf16_t* Wlat_t = (bf16_t*)(ws + WS_WLAT); bf16_t* Wq_t = (bf16_t*)(ws + WS_WQ);
    bf16_t* Wuk_t = (bf16_t*)(ws + WS_WUK); bf16_t* Wuv_t = (bf16_t*)(ws + WS_WUV); bf16_t* Wo_t = (bf16_t*)(ws + WS_WO);
    float* LAT = (float*)(ws + WS_LAT); bf16_t* CQ = (bf16_t*)(ws + WS_CQ); bf16_t* CKV = (bf16_t*)(ws + WS_CKV); bf16_t* CKV2 = (bf16_t*)(ws + WS_CKV2); bf16_t* KR = (bf16_t*)(ws + WS_KR);
    bf16_t* Qb = (bf16_t*)(ws + WS_Q); bf16_t* KN = (bf16_t*)(ws + WS_KN); bf16_t* VT = (bf16_t*)(ws + WS_VT); bf16_t* Ob = (bf16_t*)(ws + WS_O); bf16_t* PD = (bf16_t*)(ws + WS_PD);
    if (threadIdx.x < 64) ((LAS unsigned*)(lds + RING_BYTES))[threadIdx.x] = 0u;
    __syncthreads();
    const XcdBarrier xbar = xcd_barrier_post((unsigned*)(ws + WS_CTL) + CW_BAR, (volatile LAS unsigned*)(lds + RING_BYTES) + 8);
#define GRID_SYNC() xcd_barrier(xbar)
#define MODP(l, i) (mod + (size_t)(l) * 8 * 9216 + (i) * 1024)
#define NG(l, i) (norm_g + ((l) * 6 + (i)) * 1024)

    {
        const int tid = opaque_tid(), lane = tid & 63, wave = __builtin_amdgcn_readfirstlane(tid >> 6), gw = vcu * 8 + wave, ngw = G * 8;
        LAS float* sc = (LAS float*)(lds + 69632);
        for (int idx = tid; idx < 8192; idx += 512) { const float v = c_in[idx]; sc[(idx & 1023) * 8 + (idx >> 10)] = v / (1.0f + __expf(-v)); }
        __syncthreads();
        LAS float* scr = (LAS float*)(lds + wave * 8448);
        constexpr int I_W1 = 16 * 176, I_W2 = 44 * 32, I_WP = 4 * 8, I_WLAT = 16 * 13, I_WQ = 4 * 48, I_WUK = 2 * 32, I_WO = 16 * 32, I_ADA = 576;
        constexpr int NITEMS = I_ADA + 4 * I_W1 + 4 * I_W2 + 4 * I_WP + I_WLAT + I_WQ + 2 * I_WUK + I_WO;
        constexpr int NTR = NITEMS - I_ADA;
        const bool split = ngw > I_ADA;
        if (gw < I_ADA) ada_item(ada_w, ada_b, mod, sc, gw, lane);
        if (!split) for (int it = gw + ngw; it < I_ADA; it += ngw) ada_item(ada_w, ada_b, mod, sc, it, lane);
        const int tr_first = split ? (gw < I_ADA ? gw : I_ADA + (gw - I_ADA)) : gw, tr_step = split ? (gw < I_ADA ? NTR : ngw - I_ADA) : ngw;
        for (int it = tr_first; it < NTR; it += tr_step) {
            int r = it;
            if (r < 4 * I_W1) { const int q = r / I_W1; transpose_item(ffn_w_in + (size_t)q * 1024 * 5632, 1024, 5632, (bf16_t*)(ws + WS_W1 + q * W1_BYTES), 1, 0, scr, r - q * I_W1, lane); continue; } r -= 4 * I_W1;
            if (r < 4 * I_W2) { const int q = r / I_W2; transpose_item(ffn_w_out + (size_t)q * 2816 * 1024, 2816, 1024, (bf16_t*)(ws + WS_W2 + q * W2_BYTES), 0, 0, scr, r - q * I_W2, lane); continue; } r -= 4 * I_W2;
            if (r < 4 * I_WP) { const int q = r / I_WP; transpose_item(pool_w + (size_t)q * 65536, 256, 256, Wp_t, 0, q * 256, scr, r - q * I_WP, lane); continue; } r -= 4 * I_WP;
            if (r < I_WLAT) { transpose_item(mla_w_in, 1024, 416, Wlat_t, 3, 0, scr, r, lane); continue; } r -= I_WLAT;
            if (r < I_WQ) { transpose_item(mla_w_uq, 256, 1536, Wq_t, 2, 0, scr, r, lane); continue; } r -= I_WQ;
            if (r < I_WUK) { transpose_item(mla_w_uk, 128, 1024, Wuk_t, 0, 0, scr, r, lane); continue; } r -= I_WUK;
            if (r < I_WUK) { transpose_item(mla_w_uv, 128, 1024, Wuv_t, 0, 0, scr, r, lane); continue; } r -= I_WUK;
            transpose_item(mla_w_o, 1024, 1024, Wo_t, 0, 0, scr, r, lane);
        }
        for (int idx = bx * 512 + tid; idx < SEQ * 16; idx += G * 512) rope_entry(cosT, sinT, idx);
        for (int idx = bx * 512 + tid; idx < 96 * 1024 / 8; idx += G * 512) ((u32x4*)(Wlat_t + 416 * 1024))[idx] = (u32x4){0u, 0u, 0u, 0u};
    }
    GRID_SYNC();
    if (gridDim.x > 1048576u) grid.sync();
    rows_phase<false, true, false, false>(x_in, nullptr, nullptr, nullptr, nullptr, 0.f, NG(0, 0), MODP(0, 0), MODP(0, 1), Hb, vcu, G);
    GRID_SYNC();

#define FFN_PHASE(l, f) do { \
        { pg8::Gemm g{Hb, (const bf16_t*)(ws + WS_W1 + (size_t)((l) * 2 + (f)) * W1_BYTES), MT, 2 * FF, DM, 0}; pg8::StaticOrder S; S.init(MT, 2 * FF, G, bx); \
          pg8::EpiSwiglu E{ACT, FF}; pg8::gemm_phase(lds, g, S, E); } \
        GRID_SYNC(); \
        { pg8::Gemm g{ACT, (const bf16_t*)(ws + WS_W2 + (size_t)((l) * 2 + (f)) * W2_BYTES), MT, DM, FF, 0}; pg8::StaticOrder S; S.init(MT, DM, G, bx); \
          pg8::EpiStore E{Yb, DM, nullptr, nullptr}; pg8::gemm_phase<pg8::EpiStore, false>(lds, g, S, E); } \
        GRID_SYNC(); } while (0)

    FFN_PHASE(0, 0);
    rows_phase<true, true, false, true>(x_in, XB, Yb, NG(0, 1), MODP(0, 2), 0.5f, NG(0, 2), MODP(0, 3), MODP(0, 4), Hb, vcu, G);
    if (MT % (G * 32) == 0) {
        const int tid = opaque_tid(), lane = tid & 63, wave = __builtin_amdgcn_readfirstlane(tid >> 6);
        const int rpb = MT / G, r0 = vcu * rpb, tb = r0 & (SEQ - 1);
        const int hrow = wave < 4 ? r0 - 8 + 2 * wave : r0 + rpb + 2 * (wave - 4);
        const bool hvalid = wave < 4 ? (tb >= 8) : (tb + rpb + 8 <= SEQ);
        if (hvalid) rows_range<true, true, false, false, false>(x_in, nullptr, Yb, NG(0, 1), MODP(0, 2), 0.5f, NG(0, 2), MODP(0, 3), MODP(0, 4), Hb, hrow, 2, lane);
        asm volatile("s_waitcnt vmcnt(0)" ::: "memory");
        __syncthreads();
        if (tid == 0) { __builtin_amdgcn_fence(__ATOMIC_ACQUIRE, "agent"); asm volatile("s_waitcnt vmcnt(0)" ::: "memory"); }
        __syncthreads();
        for (int ci = r0 / 32; ci < (r0 + rpb) / 32; ++ci) {
            const int b = ci >> 7, t0 = (ci & 127) * 32, gsel = wave >> 1;
            if (gsel == 0) pool_chunk<2>(Hb, PD, b, t0, tid);
            else if (gsel == 1) pool_chunk<4>(Hb, PD, b, t0, tid);
            else if (gsel == 2) pool_chunk<8>(Hb, PD, b, t0, tid);
            else pool_chunk<16>(Hb, PD, b, t0, tid);
        }
    } else {
        GRID_SYNC();
        for (int ci = vcu; ci < MT / 32; ci += G) {
            const int tid = opaque_tid(), wave = __builtin_amdgcn_readfirstlane(tid >> 6);
            const int b = ci >> 7, t0 = (ci & 127) * 32, gsel = wave >> 1;
            if (gsel == 0) pool_chunk<2>(Hb, PD, b, t0, tid);
            else if (gsel == 1) pool_chunk<4>(Hb, PD, b, t0, tid);
            else if (gsel == 2) pool_chunk<8>(Hb, PD, b, t0, tid);
            else pool_chunk<16>(Hb, PD, b, t0, tid);
        }
    }
    GRID_SYNC();
    {
        pg8::Gemm g{PD, Wp_t, MT, DM, 256, (size_t)MT * 256 * 2}; pg8::StaticOrder S; S.init(MT, DM, G, bx);
        pg8::EpiStore E{Yb, DM, pool_b, pool_scale};
        pg8::gemm_phase<pg8::EpiStore, false>(lds, g, S, E);
    }
    GRID_SYNC();
    rows_phase<true, true, true, true>(XB, XB, Yb, NG(0, 3), MODP(0, 5), 1.0f, NG(0, 4), MODP(0, 6), MODP(0, 7), Hb, vcu, G);
    GRID_SYNC();
    FFN_PHASE(0, 1);
    rows_phase<true, true, true, true>(XB, XB, Yb, NG(0, 5), MODP(0, 8), 0.5f, NG(1, 0), MODP(1, 0), MODP(1, 1), Hb, vcu, G);
    GRID_SYNC();

    FFN_PHASE(1, 0);
    rows_phase<true, true, true, true>(XB, XB, Yb, NG(1, 1), MODP(1, 2), 0.5f, NG(1, 2), MODP(1, 3), MODP(1, 4), Hb, vcu, G);
    GRID_SYNC();
    if (G * 1 == (MT / 256) * 2) {
        pg8::Gemm g{Hb, Wlat_t, MT, 512, DM, 0}; pg8::StaticOrder S; S.init(MT, 512, G, bx);
        pg8::EpiLat E{mla_q_norm, mla_kv_norm, cosT, sinT, CQ, CKV, CKV2, KR};
        pg8::gemm_phase(lds, g, S, E);
    } else {
        {
            pg8::Gemm g{Hb, Wlat_t, MT, 512, DM, 0}; pg8::StaticOrder S; S.init(MT, 512, G, bx);
            pg8::EpiF32 E{LAT, 512};
            pg8::gemm_phase(lds, g, S, E);
        }
        GRID_SYNC();
        lat_rows_phase(LAT, mla_q_norm, mla_kv_norm, cosT, sinT, CQ, CKV, CKV2, KR, vcu, G);
    }
    GRID_SYNC();
    {
        pg8::Gemm g{CQ, Wq_t, MT, 1536, 256, 0}; pg8::StaticOrder S; S.init(MT, 1536, G, bx);
        pg8::EpiQ E{Qb, cosT, sinT};
        pg8::gemm_phase<pg8::EpiQ, false>(lds, g, S, E);
    }
    {
        pg8::Gemm g{CKV, Wuk_t, MT, 1024, 128, 0}; pg8::StaticOrder S; S.init(MT, 1024, G, bx);
        pg8::EpiStore E{KN, 1024, nullptr, nullptr};
        pg8::gemm_phase<pg8::EpiStore, false>(lds, g, S, E);
    }
    {
        pg8::Gemm g{Wuv_t, CKV2, 1024, MT, 128, 0}; pg8::StaticOrder S; S.init(1024, MT, G, bx);
        pg8::EpiStore E{VT, MT, nullptr, nullptr};
        pg8::gemm_phase<pg8::EpiStore, false>(lds, g, S, E);
    }
    GRID_SYNC();
    for (int U = vcu; U < NB * NH * 16; U += G) {
        const int bh = U >> 4, qb = U & 15;
        att::unit(lds, Qb, KN, KR, VT, Ob, bh >> 4, bh & 15, qb);
    }
    GRID_SYNC();
    {
        pg8::Gemm g{Ob, Wo_t, MT, DM, DM, 0}; pg8::StaticOrder S; S.init(MT, DM, G, bx);
        pg8::EpiStore E{Yb, DM, nullptr, nullptr};
        pg8::gemm_phase<pg8::EpiStore, false>(lds, g, S, E);
    }
    GRID_SYNC();
    rows_phase<true, true, true, true>(XB, XB2, Yb, NG(1, 3), MODP(1, 5), 1.0f, NG(1, 4), MODP(1, 6), MODP(1, 7), Hb, vcu, G);
    GRID_SYNC();
    FFN_PHASE(1, 1);
    rows_phase<true, false, true, false>(XB2, X, Yb, NG(1, 5), MODP(1, 8), 0.5f, nullptr, nullptr, nullptr, nullptr, vcu, G);
}

extern "C" void kernel_launch(void* const* d_in, const int* in_sizes, int n_in, void* d_out, int out_size, void* d_ws, size_t ws_size, hipStream_t stream) {
    static int grid = 0;
    if (grid == 0) {
        if (n_in != 17 || out_size != MT * DM || ws_size < WS_END) { fprintf(stderr, "kernel_launch: unexpected shapes (n_in %d out %d ws %zu)\n", n_in, out_size, ws_size); grid = -1; return; }
        int dev = 0, cus = 0, per_cu = 0;
        hipGetDevice(&dev);
        hipDeviceGetAttribute(&cus, hipDeviceAttributeMultiprocessorCount, dev);
        hipFuncSetAttribute((const void*)fwd_megakernel, hipFuncAttributeMaxDynamicSharedMemorySize, LDS_BYTES);
        hipOccupancyMaxActiveBlocksPerMultiprocessor(&per_cu, (const void*)fwd_megakernel, 512, LDS_BYTES);
        (void)hipGetLastError();
        if (per_cu < 1) { fprintf(stderr, "kernel_launch: occupancy query says %d blocks per CU\n", per_cu); per_cu = 1; }
        grid = cus;
    }
    if (grid < 0) return;
    if (hipMemsetAsync((char*)d_ws + WS_CTL, 0, 65536, stream) != hipSuccess) { fprintf(stderr, "kernel_launch: memset of control words failed\n"); return; }
    Args a{};
    for (int i = 0; i < 17; ++i) a.in[i] = (const float*)d_in[i];
    a.out = (float*)d_out; a.ws = (unsigned char*)d_ws;
    void* args[] = {&a};
    hipError_t e = hipLaunchCooperativeKernel((const void*)fwd_megakernel, dim3(grid), dim3(512), args, LDS_BYTES, stream);
    if (e != hipSuccess) fprintf(stderr, "cooperative launch failed: %s (grid %d)\n", hipGetErrorString(e), grid);
}
```
